# Optimizing an MI355X kernel written in HIP

```python
import jax, jax.numpy as jnp
from jax import lax
import numpy as np

D_MODEL = 1024
BATCH = 4
SEQ = 4096
DEPTH = 2

CHUNK = 64
N_A_LAYERS = DEPTH // 2
N_B_LAYERS = DEPTH - N_A_LAYERS
MLA_HEADS = 8
Q_LORA = 384
KV_LORA = 256
NOPE_DIM = 128
ROPE_DIM = 64
V_DIM = 128
ROPE_THETA = 10000.0
Q_BLOCK = 128
B_HEADS = 16
B_HEAD_DIM = 64
LEFT_CHUNKS = 8
BAND = (LEFT_CHUNKS + 1) * CHUNK
MAX_REL = 256
REL_TABLE = MAX_REL + CHUNK
D_FF = -(-8 * D_MODEL // (3 * 256)) * 256
EPS = 1e-6

kernel_name = "yoco_mla_chunked_relbias_swiglu_sandwich"


def rms_norm(x, g):
    xf = x.astype(jnp.float32)
    y = xf * lax.rsqrt(jnp.mean(xf * xf, axis=-1, keepdims=True) + EPS)
    return (y * g.astype(jnp.float32)).astype(x.dtype)


def rope_tables(positions, dtype):
    inv = 1.0 / (ROPE_THETA ** (jnp.arange(0, ROPE_DIM, 2, dtype=jnp.float32) / ROPE_DIM))
    ang = positions.astype(jnp.float32)[..., None] * inv
    return jnp.cos(ang).astype(dtype), jnp.sin(ang).astype(dtype)


def apply_rope(t, cos, sin):
    t1, t2 = jnp.split(t, 2, axis=-1)
    return jnp.concatenate([t1 * cos - t2 * sin, t2 * cos + t1 * sin], axis=-1)


def swiglu(h, w_gate, w_up, w_down):
    return (jax.nn.silu(h @ w_gate) * (h @ w_up)) @ w_down


def mla_mixer(h, cos, sin, w_a, g_q, w_uq, g_kv, w_ukv, w_o):
    B, S, _ = h.shape
    a = h @ w_a
    cq, ckv, kr = jnp.split(a, [Q_LORA, Q_LORA + KV_LORA], axis=-1)
    q = (rms_norm(cq, g_q) @ w_uq).reshape(B, S, MLA_HEADS, NOPE_DIM + ROPE_DIM)
    q_nope = q[..., :NOPE_DIM]
    q_rope = apply_rope(q[..., NOPE_DIM:], cos[:, :, None], sin[:, :, None])
    kv = (rms_norm(ckv, g_kv) @ w_ukv).reshape(B, S, MLA_HEADS, NOPE_DIM + V_DIM)
    k_nope, v = kv[..., :NOPE_DIM], kv[..., NOPE_DIM:]
    k_rope = apply_rope(kr, cos, sin)
    scale = (NOPE_DIM + ROPE_DIM) ** -0.5
    n_blk = S // Q_BLOCK
    key_chunk = jnp.arange(S) // CHUNK

    def to_blocks(t):
        return jnp.moveaxis(t.reshape(B, n_blk, Q_BLOCK, *t.shape[2:]), 1, 0)

    def block_attn(args):
        qn, qr, blk = args
        s = (jnp.einsum('bqhd,bkhd->bhqk', qn, k_nope, preferred_element_type=jnp.float32)
             + jnp.einsum('bqhr,bkr->bhqk', qr, k_rope, preferred_element_type=jnp.float32)) * scale
        q_chunk = (blk * Q_BLOCK + jnp.arange(Q_BLOCK)) // CHUNK
        mask = key_chunk[None, :] <= q_chunk[:, None]
        s = jnp.where(mask[None, None], s, -jnp.inf)
        p = jax.nn.softmax(s, axis=-1).astype(v.dtype)
        return jnp.einsum('bhqk,bkhd->bqhd', p, v)

    o = lax.map(block_attn, (to_blocks(q_nope), to_blocks(q_rope), jnp.arange(n_blk)))
    o = jnp.moveaxis(o, 0, 1).reshape(B, S, MLA_HEADS * V_DIM)
    return o @ w_o


def gather_band(t):
    B, S = t.shape[:2]
    n_c = S // CHUNK
    tp = jnp.pad(t, ((0, 0), (LEFT_CHUNKS * CHUNK, 0), (0, 0), (0, 0)))
    tp = tp.reshape(B, n_c + LEFT_CHUNKS, CHUNK, *t.shape[2:])
    band = jnp.stack([tp[:, j:j + n_c] for j in range(LEFT_CHUNKS + 1)], axis=2)
    return band.reshape(B, n_c, BAND, *t.shape[2:])


def shared_kv(x, g_src, w_kv):
    B, S, _ = x.shape
    kv = (rms_norm(x, g_src) @ w_kv).reshape(B, S, 2, B_HEADS, B_HEAD_DIM)
    return gather_band(kv[:, :, 0]), gather_band(kv[:, :, 1])


def chunked_mixer(h, k_band, v_band, w_q, rel_table, w_o):
    B, S, _ = h.shape
    n_c = S // CHUNK
    q = (h @ w_q).reshape(B, n_c, CHUNK, B_HEADS, B_HEAD_DIM)
    dist = LEFT_CHUNKS * CHUNK + jnp.arange(CHUNK)[:, None] - jnp.arange(BAND)[None, :]
    idx = jnp.clip(dist, -(CHUNK - 1), MAX_REL) + (CHUNK - 1)
    bias = rel_table.astype(jnp.float32)[:, idx]
    valid = (jnp.arange(n_c)[:, None] - LEFT_CHUNKS + jnp.arange(BAND)[None, :] // CHUNK) >= 0
    s = jnp.einsum('bnqhd,bnkhd->bnhqk', q, k_band, preferred_element_type=jnp.float32)
    s = s * (B_HEAD_DIM ** -0.5) + bias[None, None]
    s = jnp.where(valid[None, :, None, None, :], s, -jnp.inf)
    p = jax.nn.softmax(s, axis=-1).astype(v_band.dtype)
    o = jnp.einsum('bnhqk,bnkhd->bnqhd', p, v_band).reshape(B, S, B_HEADS * B_HEAD_DIM)
    return o @ w_o


def setup_inputs(seed: int = 0) -> dict:
    key = jax.random.key(seed)
    ks = iter(jax.random.split(key, 32))
    f32 = jnp.float32

    def w(shape, fan_in):
        return jax.random.normal(next(ks), shape, f32) * (fan_in ** -0.5)

    def gain(shape):
        return 1.0 + 0.05 * jax.random.normal(next(ks), shape, f32)

    x = jax.random.normal(next(ks), (BATCH, SEQ, D_MODEL), f32)
    offsets = jax.random.randint(next(ks), (BATCH, 1), 0, 4096, dtype=jnp.int32)
    positions = (jnp.arange(SEQ, dtype=jnp.int32)[None, :] + offsets).astype(jnp.int32)
    return {
        "x": x,
        "positions": positions,
        "attn_pre_g": gain((DEPTH, D_MODEL)),
        "attn_post_g": gain((DEPTH, D_MODEL)),
        "ffn_pre_g": gain((DEPTH, D_MODEL)),
        "ffn_post_g": gain((DEPTH, D_MODEL)),
        "ffn_w_gate": w((DEPTH, D_MODEL, D_FF), D_MODEL),
        "ffn_w_up": w((DEPTH, D_MODEL, D_FF), D_MODEL),
        "ffn_w_down": w((DEPTH, D_FF, D_MODEL), D_FF),
        "mla_w_a": w((N_A_LAYERS, D_MODEL, Q_LORA + KV_LORA + ROPE_DIM), D_MODEL),
        "mla_g_q": gain((N_A_LAYERS, Q_LORA)),
        "mla_w_uq": w((N_A_LAYERS, Q_LORA, MLA_HEADS * (NOPE_DIM + ROPE_DIM)), Q_LORA),
        "mla_g_kv": gain((N_A_LAYERS, KV_LORA)),
        "mla_w_ukv": w((N_A_LAYERS, KV_LORA, MLA_HEADS * (NOPE_DIM + V_DIM)), KV_LORA),
        "mla_w_o": w((N_A_LAYERS, MLA_HEADS * V_DIM, D_MODEL), MLA_HEADS * V_DIM),
        "kv_src_g": gain((D_MODEL,)),
        "w_kv_shared": w((D_MODEL, 2 * B_HEADS * B_HEAD_DIM), D_MODEL),
        "b_w_q": w((N_B_LAYERS, D_MODEL, B_HEADS * B_HEAD_DIM), D_MODEL),
        "b_rel_table": 0.2 * jax.random.normal(next(ks), (N_B_LAYERS, B_HEADS, REL_TABLE), f32),
        "b_w_o": w((N_B_LAYERS, B_HEADS * B_HEAD_DIM, D_MODEL), B_HEADS * B_HEAD_DIM),
    }


def reference(x, positions, attn_pre_g, attn_post_g, ffn_pre_g, ffn_post_g,
              ffn_w_gate, ffn_w_up, ffn_w_down,
              mla_w_a, mla_g_q, mla_w_uq, mla_g_kv, mla_w_ukv, mla_w_o,
              kv_src_g, w_kv_shared, b_w_q, b_rel_table, b_w_o):
    cos, sin = rope_tables(positions, x.dtype)
    k_band = v_band = None
    for layer in range(DEPTH):
        h = rms_norm(x, attn_pre_g[layer])
        if layer < N_A_LAYERS:
            a = layer
            y = mla_mixer(h, cos, sin, mla_w_a[a], mla_g_q[a], mla_w_uq[a],
                          mla_g_kv[a], mla_w_ukv[a], mla_w_o[a])
        else:
            b = layer - N_A_LAYERS
            y = chunked_mixer(h, k_band, v_band, b_w_q[b], b_rel_table[b], b_w_o[b])
        x = x + rms_norm(y, attn_post_g[layer])
        h = rms_norm(x, ffn_pre_g[layer])
        f = swiglu(h, ffn_w_gate[layer], ffn_w_up[layer], ffn_w_down[layer])
        x = x + rms_norm(f, ffn_post_g[layer])
        if layer == N_A_LAYERS - 1:
            k_band, v_band = shared_kv(x, kv_src_g, w_kv_shared)
    return x
```

```cpp
#include <hip/hip_runtime.h>
#include <cstdint>
#include <cstdio>

typedef unsigned short bf16_t;
typedef short bf16x8 __attribute__((ext_vector_type(8)));
typedef float f32x4 __attribute__((ext_vector_type(4)));
typedef unsigned u32x4 __attribute__((ext_vector_type(4)));
typedef unsigned u32x2 __attribute__((ext_vector_type(2)));

constexpr int BATCH = 4, SEQ = 4096, T = BATCH * SEQ, D = 1024, DFF = 2816;
constexpr int QL = 384, KVL = 256, ROPE = 64, NOPE = 128, VD = 128, MH = 8;
constexpr int NA = 768;
constexpr int NQ = MH * (NOPE + ROPE);
constexpr int NKV = MH * (NOPE + VD);
constexpr int BH = 16, BD = 64, RELT = 320;
constexpr float EPS = 1e-6f;

__device__ __forceinline__ unsigned f2bf(float f) { unsigned u = __builtin_bit_cast(unsigned, f); return (u + 0x7fffu + ((u >> 16) & 1u)) >> 16; }
__device__ __forceinline__ unsigned pk2(float lo, float hi) { return f2bf(lo) | (f2bf(hi) << 16); }
__device__ __forceinline__ float bf2f(unsigned short b) { return __builtin_bit_cast(float, (unsigned)b << 16); }
__device__ __forceinline__ float bflo(unsigned w) { return __builtin_bit_cast(float, w << 16); }
__device__ __forceinline__ float bfhi(unsigned w) { return __builtin_bit_cast(float, w & 0xffff0000u); }
__device__ __forceinline__ float wave_sum(float v) {
#pragma unroll
    for (int o = 1; o < 64; o <<= 1) v += __shfl_xor(v, o);
    return v;
}

constexpr size_t MiB = 1u << 20;
constexpr size_t WS_COS = 1 * MiB, WS_SIN = 3 * MiB;
constexpr size_t WS_KR = 6 * MiB;
constexpr size_t WS_W = 8 * MiB;
constexpr size_t W_A = WS_W;
constexpr size_t W_UQ = W_A + (size_t)NA * D * 2;
constexpr size_t W_UKV = W_UQ + (size_t)NQ * QL * 2;
constexpr size_t W_O = W_UKV + (size_t)NKV * KVL * 2;
constexpr size_t W_GU0 = W_O + (size_t)D * D * 2;
constexpr size_t W_D0 = W_GU0 + (size_t)2 * DFF * D * 2;
constexpr size_t W_GU1 = W_D0 + (size_t)D * DFF * 2;
constexpr size_t W_D1 = W_GU1 + (size_t)2 * DFF * D * 2;
constexpr size_t W_KVQ = W_D1 + (size_t)D * DFF * 2;
constexpr size_t W_BO = W_KVQ + (size_t)3072 * D * 2;
constexpr size_t W_END = W_BO + (size_t)D * D * 2;
static_assert(W_END <= 58 * MiB, "weights fit");
constexpr size_t WS_XN = 58 * MiB;
constexpr size_t WS_R = 90 * MiB;
constexpr size_t WS_ALAT = WS_R;
constexpr size_t WS_O = WS_R;
constexpr size_t WS_Q = 122 * MiB;
constexpr size_t WS_KV = 170 * MiB;
constexpr size_t WS_Y0 = 170 * MiB;
constexpr size_t WS_H = WS_R;
constexpr size_t WS_YF = 186 * MiB;
constexpr size_t WS_KVQ = WS_R;
constexpr size_t WS_O1 = 186 * MiB;
constexpr size_t WS_Y1 = WS_R;

enum { WM_PLAIN = 0, WM_GU = 1, WM_WA = 2, WM_WUQ = 3 };
__device__ __forceinline__ int src_col(int mode, int n, int nsrc, int& which) {
    which = 0;
    if (mode == WM_PLAIN) return n < nsrc ? n : -1;
    if (mode == WM_GU) { const int G = 64; const int pn = n / (2 * G), r = n % (2 * G); which = r / G; return G * pn + (r % G); }
    if (mode == WM_WA) { if (n < 640) return n; if (n < 704) { const int j = n - 640; return 640 + (j >> 1) + 32 * (j & 1); } return -1; }
      { const int h = n / 192, d = n % 192; if (d < 128) return n; const int j = d - 128; return 192 * h + 128 + (j >> 1) + 32 * (j & 1); }
}
__global__ __launch_bounds__(256) void k_wconv(const float* W0, const float* W1, const float* g, int K, int Nsrc, bf16_t* Wt, int mode) {
    __shared__ float tile[32][33];
    const int n0 = blockIdx.x * 32, k0 = blockIdx.y * 32, tx = threadIdx.x & 31, ty = threadIdx.x >> 5;
    int which; const int sc = src_col(mode, n0 + tx, Nsrc, which);
    const float* W = which ? W1 : W0;
#pragma unroll
    for (int i = 0; i < 4; ++i) { const int k = k0 + ty + 8 * i; float v = 0.f; if (sc >= 0) { v = W[(size_t)k * Nsrc + sc]; if (g) v *= g[k]; } tile[ty + 8 * i][tx] = v; }
    __syncthreads();
#pragma unroll
    for (int i = 0; i < 4; ++i) { const int n = n0 + ty + 8 * i; Wt[(size_t)n * K + k0 + tx] = (bf16_t)f2bf(tile[tx][ty + 8 * i]); }
}

__global__ void k_rope_table(const int* pos, float* cosT, float* sinT) {
    const int idx = blockIdx.x * blockDim.x + threadIdx.x; if (idx >= T * 32) return;
    const int t = idx >> 5, i = idx & 31;
    const float inv = 1.0f / powf(10000.0f, (float)(2 * i) / 64.0f);
    const float ang = (float)pos[t] * inv;
    float s, c; sincosf(ang, &s, &c);
    cosT[idx] = c; sinT[idx] = s;
}

__global__ __launch_bounds__(256) void k_rows_pre(const float* x, bf16_t* XN) {
    const int row = blockIdx.x * 4 + (threadIdx.x >> 6), lane = threadIdx.x & 63;
    const f32x4* xr = (const f32x4*)(x + (size_t)row * D) + lane;
    f32x4 v[4]; float s = 0.f;
#pragma unroll
    for (int j = 0; j < 4; ++j) { v[j] = xr[64 * j]; s += v[j].x * v[j].x + v[j].y * v[j].y + v[j].z * v[j].z + v[j].w * v[j].w; }
    const float rstd = rsqrtf(wave_sum(s) * (1.f / D) + EPS);
    u32x2* o = (u32x2*)(XN + (size_t)row * D) + lane;
#pragma unroll
    for (int j = 0; j < 4; ++j) { u32x2 w; w.x = pk2(v[j].x * rstd, v[j].y * rstd); w.y = pk2(v[j].z * rstd, v[j].w * rstd); o[64 * j] = w; }
}
__global__ __launch_bounds__(256) void k_rows_post(const float* xin, const float* Y, const float* g, float* xout, bf16_t* XN) {
    const int row = blockIdx.x * 4 + (threadIdx.x >> 6), lane = threadIdx.x & 63;
    const f32x4* yr = (const f32x4*)(Y + (size_t)row * D) + lane;
    const f32x4* xr = (const f32x4*)(xin + (size_t)row * D) + lane;
    const f32x4* gr = (const f32x4*)g + lane;
    f32x4 y[4]; float s = 0.f;
#pragma unroll
    for (int j = 0; j < 4; ++j) { y[j] = yr[64 * j]; s += y[j].x * y[j].x + y[j].y * y[j].y + y[j].z * y[j].z + y[j].w * y[j].w; }
    const float rstd = rsqrtf(wave_sum(s) * (1.f / D) + EPS);
    float s2 = 0.f;
#pragma unroll
    for (int j = 0; j < 4; ++j) { const f32x4 xv = xr[64 * j], gv = gr[64 * j]; y[j] = xv + y[j] * rstd * gv; s2 += y[j].x * y[j].x + y[j].y * y[j].y + y[j].z * y[j].z + y[j].w * y[j].w; }
    f32x4* xo = (f32x4*)(xout + (size_t)row * D) + lane;
#pragma unroll
    for (int j = 0; j < 4; ++j) xo[64 * j] = y[j];
    if (XN) {
        const float r2 = rsqrtf(wave_sum(s2) * (1.f / D) + EPS);
        u32x2* o = (u32x2*)(XN + (size_t)row * D) + lane;
#pragma unroll
        for (int j = 0; j < 4; ++j) { u32x2 w; w.x = pk2(y[j].x * r2, y[j].y * r2); w.y = pk2(y[j].z * r2, y[j].w * r2); o[64 * j] = w; }
    }
}
__global__ __launch_bounds__(256) void k_lat_post(bf16_t* A, const float* cosT, const float* sinT, bf16_t* KR) {
    const int row = blockIdx.x * 4 + (threadIdx.x >> 6), lane = threadIdx.x & 63;
    bf16_t* a = A + (size_t)row * NA;
    float q[6], kv[4]; float sq = 0.f, sk = 0.f;
#pragma unroll
    for (int j = 0; j < 6; ++j) { q[j] = bf2f(a[lane + 64 * j]); sq += q[j] * q[j]; }
#pragma unroll
    for (int j = 0; j < 4; ++j) { kv[j] = bf2f(a[QL + lane + 64 * j]); sk += kv[j] * kv[j]; }
    const float rq = rsqrtf(wave_sum(sq) * (1.f / QL) + EPS), rk = rsqrtf(wave_sum(sk) * (1.f / KVL) + EPS);
#pragma unroll
    for (int j = 0; j < 6; ++j) a[lane + 64 * j] = (bf16_t)f2bf(q[j] * rq);
#pragma unroll
    for (int j = 0; j < 4; ++j) a[QL + lane + 64 * j] = (bf16_t)f2bf(kv[j] * rk);
    if (lane < 32) {
        const float t1 = bf2f(a[640 + 2 * lane]), t2 = bf2f(a[640 + 2 * lane + 1]);
        const float c = cosT[row * 32 + lane], s = sinT[row * 32 + lane];
        KR[(size_t)row * 64 + 2 * lane] = (bf16_t)f2bf(t1 * c - t2 * s);
        KR[(size_t)row * 64 + 2 * lane + 1] = (bf16_t)f2bf(t2 * c + t1 * s);
    }
}
__global__ void k_rope_q(bf16_t* Q, const float* cosT, const float* sinT) {
    const int idx = blockIdx.x * blockDim.x + threadIdx.x; if (idx >= T * MH * 32) return;
    const int i = idx & 31, h = (idx >> 5) & 7, row = idx >> 8;
    bf16_t* p = Q + (size_t)row * NQ + h * 192 + 128 + 2 * i;
    const float t1 = bf2f(p[0]), t2 = bf2f(p[1]), c = cosT[row * 32 + i], s = sinT[row * 32 + i];
    p[0] = (bf16_t)f2bf(t1 * c - t2 * s); p[1] = (bf16_t)f2bf(t2 * c + t1 * s);
}

enum { EPI_BF16 = 0, EPI_F32 = 1, EPI_SWIGLU = 2 };
template <int EPI>
__global__ __launch_bounds__(256) void k_gemm(const bf16_t* A, int lda, const bf16_t* Bt, int K, void* Cv, int ldc) {
    __shared__ __attribute__((aligned(16))) bf16_t sA[128][40];
    __shared__ __attribute__((aligned(16))) bf16_t sB[128][40];
    const int tid = threadIdx.x, w = tid >> 6, lane = tid & 63, fr = lane & 15, fq = lane >> 4;
    const int m0 = blockIdx.y * 128, n0 = blockIdx.x * 128;
    f32x4 acc[2][8];
#pragma unroll
    for (int m = 0; m < 2; ++m)
#pragma unroll
        for (int n = 0; n < 8; ++n) acc[m][n] = (f32x4){0.f, 0.f, 0.f, 0.f};
    const int lr = tid >> 2, lc = (tid & 3) * 8;
    for (int k0 = 0; k0 < K; k0 += 32) {
        u32x4 va[2], vb[2];
#pragma unroll
        for (int p = 0; p < 2; ++p) {
            va[p] = *(const u32x4*)(A + (size_t)(m0 + lr + 64 * p) * lda + k0 + lc);
            vb[p] = *(const u32x4*)(Bt + (size_t)(n0 + lr + 64 * p) * K + k0 + lc);
        }
        __syncthreads();
#pragma unroll
        for (int p = 0; p < 2; ++p) { *(u32x4*)&sA[lr + 64 * p][lc] = va[p]; *(u32x4*)&sB[lr + 64 * p][lc] = vb[p]; }
        __syncthreads();
        bf16x8 a[2], b[8];
#pragma unroll
        for (int m = 0; m < 2; ++m) a[m] = *(const bf16x8*)&sA[32 * w + 16 * m + fr][8 * fq];
#pragma unroll
        for (int n = 0; n < 8; ++n) b[n] = *(const bf16x8*)&sB[16 * n + fr][8 * fq];
#pragma unroll
        for (int m = 0; m < 2; ++m)
#pragma unroll
            for (int n = 0; n < 8; ++n) acc[m][n] = __builtin_amdgcn_mfma_f32_16x16x32_bf16(b[n], a[m], acc[m][n], 0, 0, 0);
    }
#pragma unroll
    for (int m = 0; m < 2; ++m) {
        const int row = m0 + 32 * w + 16 * m + fr;
        if (EPI == EPI_F32) {
            float* C = (float*)Cv;
#pragma unroll
            for (int n = 0; n < 8; ++n) *(f32x4*)(C + (size_t)row * ldc + n0 + 16 * n + 4 * fq) = acc[m][n];
        } else if (EPI == EPI_BF16) {
            bf16_t* C = (bf16_t*)Cv;
#pragma unroll
            for (int n = 0; n < 8; ++n) { u32x2 o; o.x = pk2(acc[m][n][0], acc[m][n][1]); o.y = pk2(acc[m][n][2], acc[m][n][3]); *(u32x2*)(C + (size_t)row * ldc + n0 + 16 * n + 4 * fq) = o; }
        } else {
            bf16_t* C = (bf16_t*)Cv;
#pragma unroll
            for (int n = 0; n < 4; ++n) {
                float h[4];
#pragma unroll
                for (int r = 0; r < 4; ++r) { const float gt = acc[m][n][r], up = acc[m][n + 4][r]; h[r] = gt / (1.f + __expf(-gt)) * up; }
                u32x2 o; o.x = pk2(h[0], h[1]); o.y = pk2(h[2], h[3]);
                *(u32x2*)(C + (size_t)row * ldc + 64 * blockIdx.x + 16 * n + 4 * fq) = o;
            }
        }
    }
}

__global__ __launch_bounds__(256) void k_mla_attn(const bf16_t* Q, const bf16_t* KV, const bf16_t* KR, bf16_t* O) {
    __shared__ __attribute__((aligned(16))) bf16_t sK[64][192 + 8];
    __shared__ __attribute__((aligned(16))) bf16_t sV[64][128 + 8];
    const int tid = threadIdx.x, qi = tid >> 2, p = tid & 3;
    const int qc = blockIdx.x & 63, h = (blockIdx.x >> 6) & 7, b = blockIdx.x >> 9;
    const size_t row0 = (size_t)b * SEQ;
    const size_t qrow = row0 + qc * 64 + qi;
    float q[48];
#pragma unroll
    for (int d = 0; d < 48; ++d) q[d] = bf2f(Q[qrow * NQ + h * 192 + 48 * p + d]);
    float o[32];
#pragma unroll
    for (int d = 0; d < 32; ++d) o[d] = 0.f;
    float m = -1e30f, l = 0.f;
    const float scale = 0.07216878364870322f;
    for (int kt = 0; kt <= qc; ++kt) {
        __syncthreads();
        for (int e = tid; e < 64 * 24; e += 256) { const int kr = e / 24, c = e % 24; const size_t krow = row0 + kt * 64 + kr;
            u32x4 v; if (c < 16) v = *(const u32x4*)(KV + krow * NKV + h * 256 + 8 * c); else v = *(const u32x4*)(KR + krow * 64 + 8 * (c - 16));
            *(u32x4*)&sK[kr][8 * c] = v; }
        for (int e = tid; e < 64 * 16; e += 256) { const int kr = e / 16, c = e % 16; const size_t krow = row0 + kt * 64 + kr;
            *(u32x4*)&sV[kr][8 * c] = *(const u32x4*)(KV + krow * NKV + h * 256 + 128 + 8 * c); }
        __syncthreads();
        for (int j0 = 0; j0 < 64; j0 += 8) {
            float s[8]; float mx = m;
#pragma unroll
            for (int jj = 0; jj < 8; ++jj) {
                float acc = 0.f;
#pragma unroll
                for (int d = 0; d < 48; d += 8) { const u32x4 kv = *(const u32x4*)&sK[j0 + jj][48 * p + d];
                    acc += q[d] * bflo(kv.x) + q[d + 1] * bfhi(kv.x) + q[d + 2] * bflo(kv.y) + q[d + 3] * bfhi(kv.y) + q[d + 4] * bflo(kv.z) + q[d + 5] * bfhi(kv.z) + q[d + 6] * bflo(kv.w) + q[d + 7] * bfhi(kv.w); }
                acc += __shfl_xor(acc, 1); acc += __shfl_xor(acc, 2);
                s[jj] = acc * scale; mx = fmaxf(mx, s[jj]);
            }
            const float alpha = __expf(m - mx); m = mx; l *= alpha;
#pragma unroll
            for (int d = 0; d < 32; ++d) o[d] *= alpha;
#pragma unroll
            for (int jj = 0; jj < 8; ++jj) {
                const float pr = __expf(s[jj] - m); l += pr;
#pragma unroll
                for (int d = 0; d < 32; d += 8) { const u32x4 vv = *(const u32x4*)&sV[j0 + jj][32 * p + d];
                    o[d] += pr * bflo(vv.x); o[d + 1] += pr * bfhi(vv.x); o[d + 2] += pr * bflo(vv.y); o[d + 3] += pr * bfhi(vv.y); o[d + 4] += pr * bflo(vv.z); o[d + 5] += pr * bfhi(vv.z); o[d + 6] += pr * bflo(vv.w); o[d + 7] += pr * bfhi(vv.w); }
            }
        }
    }
    const float rl = 1.f / l;
#pragma unroll
    for (int d = 0; d < 32; d += 2) *(unsigned*)(O + qrow * D + h * 128 + 32 * p + d) = pk2(o[d] * rl, o[d + 1] * rl);
}

__global__ __launch_bounds__(256) void k_chunk_attn(const bf16_t* KVQ, const float* rel, bf16_t* O) {
    __shared__ __attribute__((aligned(16))) bf16_t sK[64][64 + 8];
    __shared__ __attribute__((aligned(16))) bf16_t sV[64][64 + 8];
    __shared__ float sRel[RELT];
    const int tid = threadIdx.x, qi = tid >> 2, p = tid & 3;
    const int c = blockIdx.x & 63, h = (blockIdx.x >> 6) & 15, b = blockIdx.x >> 10;
    const size_t row0 = (size_t)b * SEQ;
    const int qpos = c * 64 + qi; const size_t qrow = row0 + qpos;
    for (int e = tid; e < RELT; e += 256) sRel[e] = rel[h * RELT + e];
    float q[16];
#pragma unroll
    for (int d = 0; d < 16; ++d) q[d] = bf2f(KVQ[qrow * 3072 + 2048 + h * 64 + 16 * p + d]);
    float o[16];
#pragma unroll
    for (int d = 0; d < 16; ++d) o[d] = 0.f;
    float m = -1e30f, l = 0.f;
    const int c_lo = c - 8 < 0 ? 0 : c - 8;
    for (int kc = c_lo; kc <= c; ++kc) {
        __syncthreads();
        for (int e = tid; e < 64 * 8; e += 256) { const int kr = e >> 3, cc = e & 7; const size_t krow = row0 + kc * 64 + kr;
            *(u32x4*)&sK[kr][8 * cc] = *(const u32x4*)(KVQ + krow * 3072 + h * 64 + 8 * cc);
            *(u32x4*)&sV[kr][8 * cc] = *(const u32x4*)(KVQ + krow * 3072 + 1024 + h * 64 + 8 * cc); }
        __syncthreads();
        for (int j0 = 0; j0 < 64; j0 += 8) {
            float s[8]; float mx = m;
#pragma unroll
            for (int jj = 0; jj < 8; ++jj) {
                float acc = 0.f;
#pragma unroll
                for (int d = 0; d < 16; d += 8) { const u32x4 kv = *(const u32x4*)&sK[j0 + jj][16 * p + d];
                    acc += q[d] * bflo(kv.x) + q[d + 1] * bfhi(kv.x) + q[d + 2] * bflo(kv.y) + q[d + 3] * bfhi(kv.y) + q[d + 4] * bflo(kv.z) + q[d + 5] * bfhi(kv.z) + q[d + 6] * bflo(kv.w) + q[d + 7] * bfhi(kv.w); }
                acc += __shfl_xor(acc, 1); acc += __shfl_xor(acc, 2);
                int dist = qpos - (kc * 64 + j0 + jj); dist = dist < -63 ? -63 : (dist > 256 ? 256 : dist);
                s[jj] = acc * 0.125f + sRel[dist + 63]; mx = fmaxf(mx, s[jj]);
            }
            const float alpha = __expf(m - mx); m = mx; l *= alpha;
#pragma unroll
            for (int d = 0; d < 16; ++d) o[d] *= alpha;
#pragma unroll
            for (int jj = 0; jj < 8; ++jj) {
                const float pr = __expf(s[jj] - m); l += pr;
#pragma unroll
                for (int d = 0; d < 16; d += 8) { const u32x4 vv = *(const u32x4*)&sV[j0 + jj][16 * p + d];
                    o[d] += pr * bflo(vv.x); o[d + 1] += pr * bfhi(vv.x); o[d + 2] += pr * bflo(vv.y); o[d + 3] += pr * bfhi(vv.y); o[d + 4] += pr * bflo(vv.z); o[d + 5] += pr * bfhi(vv.z); o[d + 6] += pr * bflo(vv.w); o[d + 7] += pr * bfhi(vv.w); }
            }
        }
    }
    const float rl = 1.f / l;
#pragma unroll
    for (int d = 0; d < 16; d += 2) *(unsigned*)(O + qrow * D + h * 64 + 16 * p + d) = pk2(o[d] * rl, o[d + 1] * rl);
}

static void wconv(hipStream_t st, const float* W0, const float* W1, const float* g, int K, int Nsrc, int Nout, bf16_t* Wt, int mode) {
    k_wconv<<<dim3(Nout / 32, K / 32), 256, 0, st>>>(W0, W1, g, K, Nsrc, Wt, mode);
}
template <int EPI> static void gemm(hipStream_t st, const bf16_t* A, int lda, const bf16_t* Bt, int M, int N, int K, void* C, int ldc) {
    k_gemm<EPI><<<dim3(N / 128, M / 128), 256, 0, st>>>(A, lda, Bt, K, C, ldc);
}

extern "C" void kernel_launch(void* const* d_in, const int* in_sizes, int n_in, void* d_out, int out_size, void* d_ws, size_t ws_size, hipStream_t stream) {
    const float* x = (const float*)d_in[0]; const int* pos = (const int*)d_in[1];
    const float *attn_pre_g = (const float*)d_in[2], *attn_post_g = (const float*)d_in[3], *ffn_pre_g = (const float*)d_in[4], *ffn_post_g = (const float*)d_in[5];
    const float *w_gate = (const float*)d_in[6], *w_up = (const float*)d_in[7], *w_down = (const float*)d_in[8];
    const float *w_a = (const float*)d_in[9], *g_q = (const float*)d_in[10], *w_uq = (const float*)d_in[11], *g_kv = (const float*)d_in[12], *w_ukv = (const float*)d_in[13], *w_o = (const float*)d_in[14];
    const float *kv_src_g = (const float*)d_in[15], *w_kvs = (const float*)d_in[16], *b_w_q = (const float*)d_in[17], *rel = (const float*)d_in[18], *b_w_o = (const float*)d_in[19];
    float* out = (float*)d_out; unsigned char* ws = (unsigned char*)d_ws;
    float *cosT = (float*)(ws + WS_COS), *sinT = (float*)(ws + WS_SIN);
    bf16_t *KR = (bf16_t*)(ws + WS_KR), *XN = (bf16_t*)(ws + WS_XN);
    bf16_t *Wa = (bf16_t*)(ws + W_A), *Wuq = (bf16_t*)(ws + W_UQ), *Wukv = (bf16_t*)(ws + W_UKV), *Wo = (bf16_t*)(ws + W_O);
    bf16_t *Wgu[2] = {(bf16_t*)(ws + W_GU0), (bf16_t*)(ws + W_GU1)}, *Wd[2] = {(bf16_t*)(ws + W_D0), (bf16_t*)(ws + W_D1)};
    bf16_t *Wkvq = (bf16_t*)(ws + W_KVQ), *Wbo = (bf16_t*)(ws + W_BO);

    wconv(stream, w_a, nullptr, attn_pre_g, D, 704, NA, Wa, WM_WA);
    wconv(stream, w_uq, nullptr, g_q, QL, NQ, NQ, Wuq, WM_WUQ);
    wconv(stream, w_ukv, nullptr, g_kv, KVL, NKV, NKV, Wukv, WM_PLAIN);
    wconv(stream, w_o, nullptr, nullptr, D, D, D, Wo, WM_PLAIN);
    for (int l = 0; l < 2; ++l) {
        wconv(stream, w_gate + (size_t)l * D * DFF, w_up + (size_t)l * D * DFF, ffn_pre_g + l * D, D, DFF, 2 * DFF, Wgu[l], WM_GU);
        wconv(stream, w_down + (size_t)l * DFF * D, nullptr, nullptr, DFF, D, D, Wd[l], WM_PLAIN);
    }
    wconv(stream, w_kvs, nullptr, kv_src_g, D, 2048, 2048, Wkvq, WM_PLAIN);
    wconv(stream, b_w_q, nullptr, attn_pre_g + D, D, D, D, Wkvq + (size_t)2048 * D, WM_PLAIN);
    wconv(stream, b_w_o, nullptr, nullptr, D, D, D, Wbo, WM_PLAIN);
    k_rope_table<<<T * 32 / 256, 256, 0, stream>>>(pos, cosT, sinT);

    k_rows_pre<<<T / 4, 256, 0, stream>>>(x, XN);
    bf16_t* ALAT = (bf16_t*)(ws + WS_ALAT); bf16_t* Q = (bf16_t*)(ws + WS_Q); bf16_t* KV = (bf16_t*)(ws + WS_KV); bf16_t* O = (bf16_t*)(ws + WS_O);
    gemm<EPI_BF16>(stream, XN, D, Wa, T, NA, D, ALAT, NA);
    k_lat_post<<<T / 4, 256, 0, stream>>>(ALAT, cosT, sinT, KR);
    gemm<EPI_BF16>(stream, ALAT, NA, Wuq, T, NQ, QL, Q, NQ);
    gemm<EPI_BF16>(stream, ALAT + QL, NA, Wukv, T, NKV, KVL, KV, NKV);
    k_rope_q<<<T * MH * 32 / 256, 256, 0, stream>>>(Q, cosT, sinT);
    k_mla_attn<<<BATCH * MH * 64, 256, 0, stream>>>(Q, KV, KR, O);
    float* Y0 = (float*)(ws + WS_Y0);
    gemm<EPI_F32>(stream, O, D, Wo, T, D, D, Y0, D);
    k_rows_post<<<T / 4, 256, 0, stream>>>(x, Y0, attn_post_g, out, XN);
    bf16_t* H = (bf16_t*)(ws + WS_H); float* YF = (float*)(ws + WS_YF);
    gemm<EPI_SWIGLU>(stream, XN, D, Wgu[0], T, 2 * DFF, D, H, DFF);
    gemm<EPI_F32>(stream, H, DFF, Wd[0], T, D, DFF, YF, D);
    k_rows_post<<<T / 4, 256, 0, stream>>>(out, YF, ffn_post_g, out, XN);
    bf16_t* KVQ = (bf16_t*)(ws + WS_KVQ); bf16_t* O1 = (bf16_t*)(ws + WS_O1); float* Y1 = (float*)(ws + WS_Y1);
    gemm<EPI_BF16>(stream, XN, D, Wkvq, T, 3072, D, KVQ, 3072);
    k_chunk_attn<<<BATCH * BH * 64, 256, 0, stream>>>(KVQ, rel, O1);
    gemm<EPI_F32>(stream, O1, D, Wbo, T, D, D, Y1, D);
    k_rows_post<<<T / 4, 256, 0, stream>>>(out, Y1, attn_post_g + D, out, XN);
    gemm<EPI_SWIGLU>(stream, XN, D, Wgu[1], T, 2 * DFF, D, H, DFF);
    gemm<EPI_F32>(stream, H, DFF, Wd[1], T, D, DFF, YF, D);
    k_rows_post<<<T / 4, 256, 0, stream>>>(out, YF, ffn_post_g + D, out, nullptr);
}
```

```cpp
#include <hip/hip_runtime.h>
#include <hip/hip_cooperative_groups.h>
namespace cg = cooperative_groups;
#include <cstdint>
#include <cstdio>

typedef unsigned short bf16_t;
typedef short bf16x8 __attribute__((ext_vector_type(8)));
typedef float f32x4 __attribute__((ext_vector_type(4)));
typedef unsigned u32x4 __attribute__((ext_vector_type(4)));
typedef unsigned u32x2 __attribute__((ext_vector_type(2)));

constexpr int BATCH = 4, SEQ = 4096, T = BATCH * SEQ, D = 1024, DFF = 2816;
constexpr int QL = 384, KVL = 256, ROPE = 64, NOPE = 128, VD = 128, MH = 8;
constexpr int NA = 768;
constexpr int NQ = MH * (NOPE + ROPE);
constexpr int NKV = MH * (NOPE + VD);
constexpr int BH = 16, BD = 64, RELT = 320;
constexpr float EPS = 1e-6f;

__device__ __forceinline__ unsigned f2bf(float f) { unsigned u = __builtin_bit_cast(unsigned, f); return (u + 0x7fffu + ((u >> 16) & 1u)) >> 16; }
__device__ __forceinline__ unsigned pk2(float lo, float hi) { return f2bf(lo) | (f2bf(hi) << 16); }
__device__ __forceinline__ float bf2f(unsigned short b) { return __builtin_bit_cast(float, (unsigned)b << 16); }
__device__ __forceinline__ float bflo(unsigned w) { return __builtin_bit_cast(float, w << 16); }
__device__ __forceinline__ float bfhi(unsigned w) { return __builtin_bit_cast(float, w & 0xffff0000u); }
__device__ __forceinline__ float wave_sum(float v) {
#pragma unroll
    for (int o = 1; o < 64; o <<= 1) v += __shfl_xor(v, o);
    return v;
}

constexpr size_t MiB = 1u << 20;
constexpr size_t WS_COS = 1 * MiB, WS_SIN = 3 * MiB;
constexpr size_t WS_KR = 6 * MiB;
constexpr size_t WS_W = 8 * MiB;
constexpr size_t W_A = WS_W;
constexpr size_t W_UQ = W_A + (size_t)NA * D * 2;
constexpr size_t W_UKV = W_UQ + (size_t)NQ * QL * 2;
constexpr size_t W_O = W_UKV + (size_t)NKV * KVL * 2;
constexpr size_t W_GU0 = W_O + (size_t)D * D * 2;
constexpr size_t W_D0 = W_GU0 + (size_t)2 * DFF * D * 2;
constexpr size_t W_GU1 = W_D0 + (size_t)D * DFF * 2;
constexpr size_t W_D1 = W_GU1 + (size_t)2 * DFF * D * 2;
constexpr size_t W_KVQ = W_D1 + (size_t)D * DFF * 2;
constexpr size_t W_BO = W_KVQ + (size_t)3072 * D * 2;
constexpr size_t W_END = W_BO + (size_t)D * D * 2;
static_assert(W_END <= 58 * MiB, "weights fit");
constexpr size_t WS_XN = 58 * MiB;
constexpr size_t WS_R = 90 * MiB;
constexpr size_t WS_ALAT = WS_R;
constexpr size_t WS_O = WS_R;
constexpr size_t WS_Q = 122 * MiB;
constexpr size_t WS_KV = 170 * MiB;
constexpr size_t WS_Y0 = 170 * MiB;
constexpr size_t WS_H = WS_R;
constexpr size_t WS_YF = 186 * MiB;
constexpr size_t WS_KVQ = WS_R;
constexpr size_t WS_O1 = 186 * MiB;
constexpr size_t WS_Y1 = WS_R;


#define LAS __attribute__((address_space(3)))
constexpr int NTHR = 512, NWAVE = 8;
constexpr int LDS_BYTES = 163840;

struct Params { const float* in[20]; float* out; unsigned char* ws; };

enum { WM_PLAIN = 0, WM_GU = 1, WM_WA = 2, WM_WUQ = 3 };
__device__ __forceinline__ int src_col(int mode, int n, int nsrc, int& which) {
    which = 0;
    if (mode == WM_PLAIN) return n < nsrc ? n : -1;
    if (mode == WM_GU) { const int G = 64; const int pn = n / (2 * G), r = n % (2 * G); which = r / G; return G * pn + (r % G); }
    if (mode == WM_WA) { if (n < 640) return n; if (n < 704) { const int j = n - 640; return 640 + (j >> 1) + 32 * (j & 1); } return -1; }
      { const int h = n / 192, d = n % 192; if (d < 128) return n; const int j = d - 128; return 192 * h + 128 + (j >> 1) + 32 * (j & 1); }
}
__device__ __forceinline__ void ph_wconv(char* lds, const float* W0, const float* W1, const float* g, int K, int Nsrc, int Nout, bf16_t* Wt, int mode) {
    const int half = threadIdx.x >> 8, t = threadIdx.x & 255, tx = t & 31, ty = t >> 5;
    float (*tile)[33] = (float (*)[33])(lds + half * 8192);
    const int nbx = Nout / 32, ntiles = nbx * (K / 32);
    for (int tp = blockIdx.x; tp < ntiles / 2; tp += gridDim.x) {
        const int ti = 2 * tp + half, n0 = (ti % nbx) * 32, k0 = (ti / nbx) * 32;
        int which; const int sc = src_col(mode, n0 + tx, Nsrc, which);
        const float* W = which ? W1 : W0;
        __syncthreads();
#pragma unroll
        for (int i = 0; i < 4; ++i) { const int k = k0 + ty + 8 * i; float v = 0.f; if (sc >= 0) { v = W[(size_t)k * Nsrc + sc]; if (g) v *= g[k]; } tile[ty + 8 * i][tx] = v; }
        __syncthreads();
#pragma unroll
        for (int i = 0; i < 4; ++i) { const int n = n0 + ty + 8 * i; Wt[(size_t)n * K + k0 + tx] = (bf16_t)f2bf(tile[tx][ty + 8 * i]); }
    }
}
__device__ __forceinline__ void ph_rope_table(const int* pos, float* cosT, float* sinT) {
    for (int idx = blockIdx.x * NTHR + threadIdx.x; idx < T * 32; idx += gridDim.x * NTHR) {
        const int t = idx >> 5, i = idx & 31;
        const float inv = 1.0f / powf(10000.0f, (float)(2 * i) / 64.0f);
        const float ang = (float)pos[t] * inv;
        float s, c; sincosf(ang, &s, &c);
        cosT[idx] = c; sinT[idx] = s;
    }
}
__device__ __forceinline__ void ph_rows_pre(const float* x, bf16_t* XN) {
    const int lane = threadIdx.x & 63, wv = threadIdx.x >> 6;
    for (int row = blockIdx.x * NWAVE + wv; row < T; row += gridDim.x * NWAVE) {
        const f32x4* xr = (const f32x4*)(x + (size_t)row * D) + lane;
        f32x4 v[4]; float s = 0.f;
#pragma unroll
        for (int j = 0; j < 4; ++j) { v[j] = xr[64 * j]; s += v[j].x * v[j].x + v[j].y * v[j].y + v[j].z * v[j].z + v[j].w * v[j].w; }
        const float rstd = rsqrtf(wave_sum(s) * (1.f / D) + EPS);
        u32x2* o = (u32x2*)(XN + (size_t)row * D) + lane;
#pragma unroll
        for (int j = 0; j < 4; ++j) { u32x2 w; w.x = pk2(v[j].x * rstd, v[j].y * rstd); w.y = pk2(v[j].z * rstd, v[j].w * rstd); o[64 * j] = w; }
    }
}
__device__ __forceinline__ void ph_rows_post(const float* xin, const float* Y, const float* g, float* xout, bf16_t* XN) {
    const int lane = threadIdx.x & 63, wv = threadIdx.x >> 6;
    for (int row = blockIdx.x * NWAVE + wv; row < T; row += gridDim.x * NWAVE) {
        const f32x4* yr = (const f32x4*)(Y + (size_t)row * D) + lane;
        const f32x4* xr = (const f32x4*)(xin + (size_t)row * D) + lane;
        const f32x4* gr = (const f32x4*)g + lane;
        f32x4 y[4]; float s = 0.f;
#pragma unroll
        for (int j = 0; j < 4; ++j) { y[j] = yr[64 * j]; s += y[j].x * y[j].x + y[j].y * y[j].y + y[j].z * y[j].z + y[j].w * y[j].w; }
        const float rstd = rsqrtf(wave_sum(s) * (1.f / D) + EPS);
        float s2 = 0.f;
#pragma unroll
        for (int j = 0; j < 4; ++j) { const f32x4 xv = xr[64 * j], gv = gr[64 * j]; y[j] = xv + y[j] * rstd * gv; s2 += y[j].x * y[j].x + y[j].y * y[j].y + y[j].z * y[j].z + y[j].w * y[j].w; }
        f32x4* xo = (f32x4*)(xout + (size_t)row * D) + lane;
#pragma unroll
        for (int j = 0; j < 4; ++j) xo[64 * j] = y[j];
        if (XN) {
            const float r2 = rsqrtf(wave_sum(s2) * (1.f / D) + EPS);
            u32x2* o = (u32x2*)(XN + (size_t)row * D) + lane;
#pragma unroll
            for (int j = 0; j < 4; ++j) { u32x2 w; w.x = pk2(y[j].x * r2, y[j].y * r2); w.y = pk2(y[j].z * r2, y[j].w * r2); o[64 * j] = w; }
        }
    }
}
__device__ __forceinline__ void ph_lat_post(bf16_t* A, const float* cosT, const float* sinT, bf16_t* KR) {
    const int lane = threadIdx.x & 63, wv = threadIdx.x >> 6;
    for (int row = blockIdx.x * NWAVE + wv; row < T; row += gridDim.x * NWAVE) {
        bf16_t* a = A + (size_t)row * NA;
        float q[6], kv[4]; float sq = 0.f, sk = 0.f;
#pragma unroll
        for (int j = 0; j < 6; ++j) { q[j] = bf2f(a[lane + 64 * j]); sq += q[j] * q[j]; }
#pragma unroll
        for (int j = 0; j < 4; ++j) { kv[j] = bf2f(a[QL + lane + 64 * j]); sk += kv[j] * kv[j]; }
        const float rq = rsqrtf(wave_sum(sq) * (1.f / QL) + EPS), rk = rsqrtf(wave_sum(sk) * (1.f / KVL) + EPS);
#pragma unroll
        for (int j = 0; j < 6; ++j) a[lane + 64 * j] = (bf16_t)f2bf(q[j] * rq);
#pragma unroll
        for (int j = 0; j < 4; ++j) a[QL + lane + 64 * j] = (bf16_t)f2bf(kv[j] * rk);
        if (lane < 32) {
            const float t1 = bf2f(a[640 + 2 * lane]), t2 = bf2f(a[640 + 2 * lane + 1]);
            const float c = cosT[row * 32 + lane], s = sinT[row * 32 + lane];
            KR[(size_t)row * 64 + 2 * lane] = (bf16_t)f2bf(t1 * c - t2 * s);
            KR[(size_t)row * 64 + 2 * lane + 1] = (bf16_t)f2bf(t2 * c + t1 * s);
        }
    }
}
__device__ __forceinline__ void ph_rope_q(bf16_t* Q, const float* cosT, const float* sinT) {
    for (int idx = blockIdx.x * NTHR + threadIdx.x; idx < T * MH * 32; idx += gridDim.x * NTHR) {
        const int i = idx & 31, h = (idx >> 5) & 7, row = idx >> 8;
        bf16_t* p = Q + (size_t)row * NQ + h * 192 + 128 + 2 * i;
        const float t1 = bf2f(p[0]), t2 = bf2f(p[1]), c = cosT[row * 32 + i], s = sinT[row * 32 + i];
        p[0] = (bf16_t)f2bf(t1 * c - t2 * s); p[1] = (bf16_t)f2bf(t2 * c + t1 * s);
    }
}

enum { EPI_BF16 = 0, EPI_F32 = 1, EPI_SWIGLU = 2 };
template <int EPI>
__device__ __forceinline__ void ph_gemm(char* lds, const bf16_t* A, int lda, const bf16_t* Bt, int M, int N, int K, void* Cv, int ldc) {
    bf16_t (*sA)[40] = (bf16_t (*)[40])lds;
    bf16_t (*sB)[40] = (bf16_t (*)[40])(lds + 256 * 80);
    const int tid = threadIdx.x, w = tid >> 6, lane = tid & 63, fr = lane & 15, fq = lane >> 4;
    const int nM = M / 256, nN = N / 128;
    const int lr = tid >> 2, lc = (tid & 3) * 8;
    for (int unit = blockIdx.x; unit < nM * nN; unit += gridDim.x) {
        const int pm = unit % nM, pn = unit / nM, m0 = pm * 256, n0 = pn * 128;
        f32x4 acc[2][8];
#pragma unroll
        for (int m = 0; m < 2; ++m)
#pragma unroll
            for (int n = 0; n < 8; ++n) acc[m][n] = (f32x4){0.f, 0.f, 0.f, 0.f};
        for (int k0 = 0; k0 < K; k0 += 32) {
            u32x4 va[2], vb;
#pragma unroll
            for (int p = 0; p < 2; ++p) va[p] = *(const u32x4*)(A + (size_t)(m0 + lr + 128 * p) * lda + k0 + lc);
            vb = *(const u32x4*)(Bt + (size_t)(n0 + lr) * K + k0 + lc);
            __syncthreads();
#pragma unroll
            for (int p = 0; p < 2; ++p) *(u32x4*)&sA[lr + 128 * p][lc] = va[p];
            *(u32x4*)&sB[lr][lc] = vb;
            __syncthreads();
            bf16x8 a[2], b[8];
#pragma unroll
            for (int m = 0; m < 2; ++m) a[m] = *(const bf16x8*)&sA[32 * w + 16 * m + fr][8 * fq];
#pragma unroll
            for (int n = 0; n < 8; ++n) b[n] = *(const bf16x8*)&sB[16 * n + fr][8 * fq];
#pragma unroll
            for (int m = 0; m < 2; ++m)
#pragma unroll
                for (int n = 0; n < 8; ++n) acc[m][n] = __builtin_amdgcn_mfma_f32_16x16x32_bf16(b[n], a[m], acc[m][n], 0, 0, 0);
        }
#pragma unroll
        for (int m = 0; m < 2; ++m) {
            const int row = m0 + 32 * w + 16 * m + fr;
            if (EPI == EPI_F32) {
                float* C = (float*)Cv;
#pragma unroll
                for (int n = 0; n < 8; ++n) *(f32x4*)(C + (size_t)row * ldc + n0 + 16 * n + 4 * fq) = acc[m][n];
            } else if (EPI == EPI_BF16) {
                bf16_t* C = (bf16_t*)Cv;
#pragma unroll
                for (int n = 0; n < 8; ++n) { u32x2 o; o.x = pk2(acc[m][n][0], acc[m][n][1]); o.y = pk2(acc[m][n][2], acc[m][n][3]); *(u32x2*)(C + (size_t)row * ldc + n0 + 16 * n + 4 * fq) = o; }
            } else {
                bf16_t* C = (bf16_t*)Cv;
#pragma unroll
                for (int n = 0; n < 4; ++n) {
                    float h[4];
#pragma unroll
                    for (int r = 0; r < 4; ++r) { const float gt = acc[m][n][r], up = acc[m][n + 4][r]; h[r] = gt / (1.f + __expf(-gt)) * up; }
                    u32x2 o; o.x = pk2(h[0], h[1]); o.y = pk2(h[2], h[3]);
                    *(u32x2*)(C + (size_t)row * ldc + 64 * pn + 16 * n + 4 * fq) = o;
                }
            }
        }
    }
}

__device__ __forceinline__ void ph_mla_attn(char* lds, const bf16_t* Q, const bf16_t* KV, const bf16_t* KR, bf16_t* O) {
    const int tid = threadIdx.x, qi = tid >> 3, p = tid & 7;
    bf16_t (*sK)[200] = (bf16_t (*)[200])lds;
    bf16_t (*sV)[136] = (bf16_t (*)[136])(lds + 64 * 400);
    const float scale = 0.07216878364870322f;
    for (int vb = blockIdx.x; vb < BATCH * MH * 64; vb += gridDim.x) {
        const int qc = 63 - (vb >> 5), h = vb & 7, b = (vb >> 3) & 3;
        const size_t row0 = (size_t)b * SEQ;
        const size_t qrow = row0 + qc * 64 + qi;
        float q[24];
#pragma unroll
        for (int d = 0; d < 24; ++d) q[d] = bf2f(Q[qrow * NQ + h * 192 + 24 * p + d]);
        float o[16];
#pragma unroll
        for (int d = 0; d < 16; ++d) o[d] = 0.f;
        float m = -1e30f, l = 0.f;
        for (int kt = 0; kt <= qc; ++kt) {
            __syncthreads();
            for (int e = tid; e < 64 * 24; e += NTHR) { const int kr = e / 24, c = e % 24; const size_t krow = row0 + kt * 64 + kr;
                u32x4 v; if (c < 16) v = *(const u32x4*)(KV + krow * NKV + h * 256 + 8 * c); else v = *(const u32x4*)(KR + krow * 64 + 8 * (c - 16));
                *(u32x4*)&sK[kr][8 * c] = v; }
            for (int e = tid; e < 64 * 16; e += NTHR) { const int kr = e / 16, c = e % 16; const size_t krow = row0 + kt * 64 + kr;
                *(u32x4*)&sV[kr][8 * c] = *(const u32x4*)(KV + krow * NKV + h * 256 + 128 + 8 * c); }
            __syncthreads();
            for (int j0 = 0; j0 < 64; j0 += 8) {
                float s[8]; float mx = m;
#pragma unroll
                for (int jj = 0; jj < 8; ++jj) {
                    float acc = 0.f;
#pragma unroll
                    for (int d = 0; d < 24; d += 8) { const u32x4 kv = *(const u32x4*)&sK[j0 + jj][24 * p + d];
                        acc += q[d] * bflo(kv.x) + q[d + 1] * bfhi(kv.x) + q[d + 2] * bflo(kv.y) + q[d + 3] * bfhi(kv.y) + q[d + 4] * bflo(kv.z) + q[d + 5] * bfhi(kv.z) + q[d + 6] * bflo(kv.w) + q[d + 7] * bfhi(kv.w); }
                    acc += __shfl_xor(acc, 1); acc += __shfl_xor(acc, 2); acc += __shfl_xor(acc, 4);
                    s[jj] = acc * scale; mx = fmaxf(mx, s[jj]);
                }
                const float alpha = __expf(m - mx); m = mx; l *= alpha;
#pragma unroll
                for (int d = 0; d < 16; ++d) o[d] *= alpha;
#pragma unroll
                for (int jj = 0; jj < 8; ++jj) {
                    const float pr = __expf(s[jj] - m); l += pr;
#pragma unroll
                    for (int d = 0; d < 16; d += 8) { const u32x4 vv = *(const u32x4*)&sV[j0 + jj][16 * p + d];
                        o[d] += pr * bflo(vv.x); o[d + 1] += pr * bfhi(vv.x); o[d + 2] += pr * bflo(vv.y); o[d + 3] += pr * bfhi(vv.y); o[d + 4] += pr * bflo(vv.z); o[d + 5] += pr * bfhi(vv.z); o[d + 6] += pr * bflo(vv.w); o[d + 7] += pr * bfhi(vv.w); }
                }
            }
        }
        const float rl = 1.f / l;
#pragma unroll
        for (int d = 0; d < 16; d += 2) *(unsigned*)(O + qrow * D + h * 128 + 16 * p + d) = pk2(o[d] * rl, o[d + 1] * rl);
    }
}

__device__ __forceinline__ void ph_chunk_attn(char* lds, const bf16_t* KVQ, const float* rel, bf16_t* O) {
    const int tid = threadIdx.x, qi = tid >> 3, p = tid & 7;
    bf16_t (*sK)[72] = (bf16_t (*)[72])lds;
    bf16_t (*sV)[72] = (bf16_t (*)[72])(lds + 64 * 144);
    float* sRel = (float*)(lds + 2 * 64 * 144);
    for (int vb = blockIdx.x; vb < BATCH * BH * 64; vb += gridDim.x) {
        const int c = vb & 63, h = (vb >> 6) & 15, b = vb >> 10;
        const size_t row0 = (size_t)b * SEQ;
        const int qpos = c * 64 + qi; const size_t qrow = row0 + qpos;
        __syncthreads();
        for (int e = tid; e < RELT; e += NTHR) sRel[e] = rel[h * RELT + e];
        float q[8];
#pragma unroll
        for (int d = 0; d < 8; ++d) q[d] = bf2f(KVQ[qrow * 3072 + 2048 + h * 64 + 8 * p + d]);
        float o[8];
#pragma unroll
        for (int d = 0; d < 8; ++d) o[d] = 0.f;
        float m = -1e30f, l = 0.f;
        const int c_lo = c - 8 < 0 ? 0 : c - 8;
        for (int kc = c_lo; kc <= c; ++kc) {
            __syncthreads();
            { const int kr = tid >> 3, cc = tid & 7; const size_t krow = row0 + kc * 64 + kr;
                *(u32x4*)&sK[kr][8 * cc] = *(const u32x4*)(KVQ + krow * 3072 + h * 64 + 8 * cc);
                *(u32x4*)&sV[kr][8 * cc] = *(const u32x4*)(KVQ + krow * 3072 + 1024 + h * 64 + 8 * cc); }
            __syncthreads();
            for (int j0 = 0; j0 < 64; j0 += 8) {
                float s[8]; float mx = m;
#pragma unroll
                for (int jj = 0; jj < 8; ++jj) {
                    const u32x4 kv = *(const u32x4*)&sK[j0 + jj][8 * p];
                    float acc = q[0] * bflo(kv.x) + q[1] * bfhi(kv.x) + q[2] * bflo(kv.y) + q[3] * bfhi(kv.y) + q[4] * bflo(kv.z) + q[5] * bfhi(kv.z) + q[6] * bflo(kv.w) + q[7] * bfhi(kv.w);
                    acc += __shfl_xor(acc, 1); acc += __shfl_xor(acc, 2); acc += __shfl_xor(acc, 4);
                    int dist = qpos - (kc * 64 + j0 + jj); dist = dist < -63 ? -63 : (dist > 256 ? 256 : dist);
                    s[jj] = acc * 0.125f + sRel[dist + 63]; mx = fmaxf(mx, s[jj]);
                }
                const float alpha = __expf(m - mx); m = mx; l *= alpha;
#pragma unroll
                for (int d = 0; d < 8; ++d) o[d] *= alpha;
#pragma unroll
                for (int jj = 0; jj < 8; ++jj) {
                    const float pr = __expf(s[jj] - m); l += pr;
                    const u32x4 vv = *(const u32x4*)&sV[j0 + jj][8 * p];
                    o[0] += pr * bflo(vv.x); o[1] += pr * bfhi(vv.x); o[2] += pr * bflo(vv.y); o[3] += pr * bfhi(vv.y); o[4] += pr * bflo(vv.z); o[5] += pr * bfhi(vv.z); o[6] += pr * bflo(vv.w); o[7] += pr * bfhi(vv.w);
                }
            }
        }
        const float rl = 1.f / l;
        u32x4 w; w.x = pk2(o[0] * rl, o[1] * rl); w.y = pk2(o[2] * rl, o[3] * rl); w.z = pk2(o[4] * rl, o[5] * rl); w.w = pk2(o[6] * rl, o[7] * rl);
        *(u32x4*)(O + qrow * D + h * 64 + 8 * p) = w;
    }
}

__global__ void __launch_bounds__(NTHR, 2) mega_fwd(Params P) {
    extern __shared__ __attribute__((aligned(16))) char lds[];
    cg::grid_group grid = cg::this_grid();
    const float* x = P.in[0]; const int* pos = (const int*)P.in[1];
    const float *attn_pre_g = P.in[2], *attn_post_g = P.in[3], *ffn_pre_g = P.in[4], *ffn_post_g = P.in[5];
    const float *w_gate = P.in[6], *w_up = P.in[7], *w_down = P.in[8];
    const float *w_a = P.in[9], *g_q = P.in[10], *w_uq = P.in[11], *g_kv = P.in[12], *w_ukv = P.in[13], *w_o = P.in[14];
    const float *kv_src_g = P.in[15], *w_kvs = P.in[16], *b_w_q = P.in[17], *rel = P.in[18], *b_w_o = P.in[19];
    float* out = P.out; unsigned char* ws = P.ws;
    float *cosT = (float*)(ws + WS_COS), *sinT = (float*)(ws + WS_SIN);
    bf16_t *KR = (bf16_t*)(ws + WS_KR), *XN = (bf16_t*)(ws + WS_XN);
    bf16_t *Wa = (bf16_t*)(ws + W_A), *Wuq = (bf16_t*)(ws + W_UQ), *Wukv = (bf16_t*)(ws + W_UKV), *Wo = (bf16_t*)(ws + W_O);
    bf16_t *Wgu0 = (bf16_t*)(ws + W_GU0), *Wgu1 = (bf16_t*)(ws + W_GU1), *Wd0 = (bf16_t*)(ws + W_D0), *Wd1 = (bf16_t*)(ws + W_D1);
    bf16_t *Wkvq = (bf16_t*)(ws + W_KVQ), *Wbo = (bf16_t*)(ws + W_BO);
    bf16_t* ALAT = (bf16_t*)(ws + WS_ALAT); bf16_t* Q = (bf16_t*)(ws + WS_Q); bf16_t* KV = (bf16_t*)(ws + WS_KV); bf16_t* O = (bf16_t*)(ws + WS_O);
    float* Y0 = (float*)(ws + WS_Y0); bf16_t* H = (bf16_t*)(ws + WS_H); float* YF = (float*)(ws + WS_YF);
    bf16_t* KVQ = (bf16_t*)(ws + WS_KVQ); bf16_t* O1 = (bf16_t*)(ws + WS_O1); float* Y1 = (float*)(ws + WS_Y1);

    ph_wconv(lds, w_a, nullptr, attn_pre_g, D, 704, NA, Wa, WM_WA);
    ph_wconv(lds, w_uq, nullptr, g_q, QL, NQ, NQ, Wuq, WM_WUQ);
    ph_wconv(lds, w_ukv, nullptr, g_kv, KVL, NKV, NKV, Wukv, WM_PLAIN);
    ph_wconv(lds, w_o, nullptr, nullptr, D, D, D, Wo, WM_PLAIN);
    ph_wconv(lds, w_gate, w_up, ffn_pre_g, D, DFF, 2 * DFF, Wgu0, WM_GU);
    ph_wconv(lds, w_down, nullptr, nullptr, DFF, D, D, Wd0, WM_PLAIN);
    ph_wconv(lds, w_gate + (size_t)D * DFF, w_up + (size_t)D * DFF, ffn_pre_g + D, D, DFF, 2 * DFF, Wgu1, WM_GU);
    ph_wconv(lds, w_down + (size_t)DFF * D, nullptr, nullptr, DFF, D, D, Wd1, WM_PLAIN);
    ph_wconv(lds, w_kvs, nullptr, kv_src_g, D, 2048, 2048, Wkvq, WM_PLAIN);
    ph_wconv(lds, b_w_q, nullptr, attn_pre_g + D, D, D, D, Wkvq + (size_t)2048 * D, WM_PLAIN);
    ph_wconv(lds, b_w_o, nullptr, nullptr, D, D, D, Wbo, WM_PLAIN);
    ph_rope_table(pos, cosT, sinT);
    ph_rows_pre(x, XN);
    grid.sync();
    ph_gemm<EPI_BF16>(lds, XN, D, Wa, T, NA, D, ALAT, NA);
    grid.sync();
    ph_lat_post(ALAT, cosT, sinT, KR);
    grid.sync();
    ph_gemm<EPI_BF16>(lds, ALAT, NA, Wuq, T, NQ, QL, Q, NQ);
    ph_gemm<EPI_BF16>(lds, ALAT + QL, NA, Wukv, T, NKV, KVL, KV, NKV);
    grid.sync();
    ph_rope_q(Q, cosT, sinT);
    grid.sync();
    ph_mla_attn(lds, Q, KV, KR, O);
    grid.sync();
    ph_gemm<EPI_F32>(lds, O, D, Wo, T, D, D, Y0, D);
    grid.sync();
    ph_rows_post(x, Y0, attn_post_g, out, XN);
    grid.sync();
    ph_gemm<EPI_SWIGLU>(lds, XN, D, Wgu0, T, 2 * DFF, D, H, DFF);
    grid.sync();
    ph_gemm<EPI_F32>(lds, H, DFF, Wd0, T, D, DFF, YF, D);
    grid.sync();
    ph_rows_post(out, YF, ffn_post_g, out, XN);
    grid.sync();
    ph_gemm<EPI_BF16>(lds, XN, D, Wkvq, T, 3072, D, KVQ, 3072);
    grid.sync();
    ph_chunk_attn(lds, KVQ, rel, O1);
    grid.sync();
    ph_gemm<EPI_F32>(lds, O1, D, Wbo, T, D, D, Y1, D);
    grid.sync();
    ph_rows_post(out, Y1, attn_post_g + D, out, XN);
    grid.sync();
    ph_gemm<EPI_SWIGLU>(lds, XN, D, Wgu1, T, 2 * DFF, D, H, DFF);
    grid.sync();
    ph_gemm<EPI_F32>(lds, H, DFF, Wd1, T, D, DFF, YF, D);
    grid.sync();
    ph_rows_post(out, YF, ffn_post_g + D, out, nullptr);
}

extern "C" void kernel_launch(void* const* d_in, const int* in_sizes, int n_in, void* d_out, int out_size, void* d_ws, size_t ws_size, hipStream_t stream) {
    static int grid_blocks = 0;
    if (grid_blocks == 0) {
        int dev = 0, cus = 0, per_cu = 0;
        (void)hipGetDevice(&dev);
        (void)hipDeviceGetAttribute(&cus, hipDeviceAttributeMultiprocessorCount, dev);
        if (hipFuncSetAttribute((const void*)mega_fwd, hipFuncAttributeMaxDynamicSharedMemorySize, LDS_BYTES) != hipSuccess) { fprintf(stderr, "hipFuncSetAttribute failed\n"); grid_blocks = -1; return; }
        if (hipOccupancyMaxActiveBlocksPerMultiprocessor(&per_cu, (const void*)mega_fwd, NTHR, LDS_BYTES) != hipSuccess || per_cu < 1) { fprintf(stderr, "occupancy query: %d\n", per_cu); grid_blocks = -1; return; }
        grid_blocks = cus * per_cu;
    }
    if (grid_blocks < 0) return;
    Params p{};
    for (int i = 0; i < 20; ++i) p.in[i] = (const float*)d_in[i];
    p.out = (float*)d_out; p.ws = (unsigned char*)d_ws;
    void* args[] = {&p};
    hipError_t e = hipLaunchCooperativeKernel((const void*)mega_fwd, dim3(grid_blocks), dim3(NTHR), args, LDS_BYTES, stream);
    if (e != hipSuccess) fprintf(stderr, "cooperative launch failed: %s (grid %d)\n", hipGetErrorString(e), grid_blocks);
}
```

```cpp
#include <hip/hip_runtime.h>
#include <hip/hip_cooperative_groups.h>
namespace cg = cooperative_groups;
#include <cstdint>
#include <type_traits>
#include <cstdio>

typedef unsigned short bf16_t;
typedef short bf16x8 __attribute__((ext_vector_type(8)));
typedef float f32x4 __attribute__((ext_vector_type(4)));
typedef unsigned u32x4 __attribute__((ext_vector_type(4)));
typedef unsigned u32x2 __attribute__((ext_vector_type(2)));

constexpr int BATCH = 4, SEQ = 4096, T = BATCH * SEQ, D = 1024, DFF = 2816;
constexpr int QL = 384, KVL = 256, ROPE = 64, NOPE = 128, VD = 128, MH = 8;
constexpr int NA = 768;
constexpr int NQ = MH * (NOPE + ROPE);
constexpr int NKV = MH * (NOPE + VD);
constexpr int BH = 16, BD = 64, RELT = 320;
constexpr float EPS = 1e-6f;

__device__ __forceinline__ unsigned f2bf(float f) { unsigned u = __builtin_bit_cast(unsigned, f); return (u + 0x7fffu + ((u >> 16) & 1u)) >> 16; }
__device__ __forceinline__ unsigned pk2(float lo, float hi) { return f2bf(lo) | (f2bf(hi) << 16); }
__device__ __forceinline__ float bf2f(unsigned short b) { return __builtin_bit_cast(float, (unsigned)b << 16); }
__device__ __forceinline__ float bflo(unsigned w) { return __builtin_bit_cast(float, w << 16); }
__device__ __forceinline__ float bfhi(unsigned w) { return __builtin_bit_cast(float, w & 0xffff0000u); }
__device__ __forceinline__ float wave_sum(float v) {
#pragma unroll
    for (int o = 1; o < 64; o <<= 1) v += __shfl_xor(v, o);
    return v;
}

__device__ __forceinline__ int lane_id() { return (int)__builtin_amdgcn_mbcnt_hi(~0u, __builtin_amdgcn_mbcnt_lo(~0u, 0u)); }
#define TID_FROM(wv) ((wv) * 64 + lane_id())

constexpr size_t MiB = 1u << 20;
constexpr size_t WS_COS = 1 * MiB, WS_SIN = 3 * MiB;
constexpr size_t WS_KR = 6 * MiB;
constexpr size_t WS_W = 8 * MiB;
constexpr size_t W_A = WS_W;
constexpr size_t W_UQ = W_A + (size_t)NA * D * 2;
constexpr size_t W_UKV = W_UQ + (size_t)NQ * QL * 2;
constexpr size_t W_O = W_UKV + (size_t)NKV * KVL * 2;
constexpr size_t W_GU0 = W_O + (size_t)D * D * 2;
constexpr size_t W_D0 = W_GU0 + (size_t)2 * DFF * D * 2;
constexpr size_t W_GU1 = W_D0 + (size_t)D * DFF * 2;
constexpr size_t W_D1 = W_GU1 + (size_t)2 * DFF * D * 2;
constexpr size_t W_KVQ = W_D1 + (size_t)D * DFF * 2;
constexpr size_t W_BO = W_KVQ + (size_t)3072 * D * 2;
constexpr size_t W_END = W_BO + (size_t)D * D * 2;
static_assert(W_END <= 58 * MiB, "weights fit");
constexpr size_t WS_XN = 58 * MiB;
constexpr size_t WS_R = 90 * MiB;
constexpr size_t WS_ALAT = WS_R;
constexpr size_t WS_O = WS_R;
constexpr size_t WS_Q = 122 * MiB;
constexpr size_t WS_KV = 170 * MiB;
constexpr size_t WS_Y0 = 170 * MiB;
constexpr size_t WS_H = WS_R;
constexpr size_t WS_YF = 186 * MiB;
constexpr size_t WS_KVQ = WS_R;
constexpr size_t WS_O1 = 186 * MiB;
constexpr size_t WS_Y1 = WS_R;


#define LAS __attribute__((address_space(3)))
constexpr int NTHR = 512, NWAVE = 8;
constexpr int LDS_BYTES = 163840;

struct Params { const float* in[20]; float* out; unsigned char* ws; };

namespace pg8 {
#define PG8_LAS __attribute__((address_space(3)))
typedef unsigned short bf16_t;
typedef short bf16x8 __attribute__((ext_vector_type(8)));
typedef float f32x4 __attribute__((ext_vector_type(4)));
typedef unsigned u32x4 __attribute__((ext_vector_type(4)));
constexpr int BM = 256, BK = 64, HALF = 128, HTB = HALF * BK * 2  , STAGE_BYTES = 8 * HTB, NXCD = 8, WGM = 8;

__host__ __device__ __forceinline__ int lds_byte(int r, int c) { const int st = (r >> 4) * 2 + (c >> 5), rr = r & 15, cc = c & 31, ob = rr * 64 + cc * 2; return st * 1024 + (ob ^ (((ob >> 9) & 1) << 5)); }
__host__ __device__ __forceinline__ void stage_rc(int b, int& R, int& C) { const int st = b / 1024, sb = b % 1024, swz = sb ^ (((sb >> 9) & 1) << 5); R = (st >> 1) * 16 + swz / 64; C = (st & 1) * 32 + (swz % 64) / 2; }
__host__ __device__ __forceinline__ int perm32(int rho) { const int n = rho >> 4, i = rho & 15; return 8 * (i >> 2) + 4 * n + (i & 3); }

struct Unit { int pm, pn; };
struct Gemm { const bf16_t* A; const bf16_t* Bt; int M, N, K, lda; };

struct StaticOrder {
    int nM, nN, nwg, G, c;
    __host__ __device__ void init(int M, int N, int G_, int c_) { nM = M / BM; nN = N / BM; nwg = nM * nN; G = G_; c = c_; }
    __host__ __device__ bool next(int i, Unit& u) const {
        const long L = (long)i * G + c; if (L >= nwg) return false;
        int wgid = (int)L; { const int q = nwg / NXCD, r = nwg % NXCD, xcd = wgid % NXCD, off = wgid / NXCD; wgid = (xcd < r ? xcd * (q + 1) : r * (q + 1) + (xcd - r) * q) + off; }
        const int nig = WGM * nN, gid = wgid / nig, fm = gid * WGM, gsz = (nM - fm) < WGM ? (nM - fm) : WGM;
        u.pm = fm + ((wgid % nig) % gsz); u.pn = (wgid % nig) / gsz; return true;
    }
    __device__ __forceinline__ void a_ready(const Unit&) const {}
    __device__ __forceinline__ void done(const Unit&) const {}
};

__device__ __forceinline__ unsigned cvt_pk_bf16(float lo, float hi) { unsigned r; asm volatile("v_cvt_pk_bf16_f32 %0, %1, %2" : "=v"(r) : "v"(lo), "v"(hi)); return r; }
typedef float f32x2 __attribute__((ext_vector_type(2)));

struct EpiF32 {
    static constexpr bool PERM = false, AFTER_DRAIN = false;
    float* C; int ldc;
    __device__ __forceinline__ void operator()(const f32x4 (&acc)[2][2][4][2], const Unit& u, int wr, int wc, int fr, int fq) const {
        const int row0 = u.pm * BM + wr * 64 + fr, col0 = u.pn * BM + wc * 32 + 4 * fq;
#pragma unroll
        for (int ai = 0; ai < 2; ++ai)
#pragma unroll
            for (int m = 0; m < 4; ++m) { float* rowp = C + (size_t)(row0 + ai * HALF + m * 16) * ldc + col0;
#pragma unroll
                for (int bj = 0; bj < 2; ++bj)
#pragma unroll
                    for (int n = 0; n < 2; ++n) *(f32x4*)(rowp + bj * HALF + n * 16) = acc[ai][bj][m][n]; }
    }
};
struct EpiBf16 {
    static constexpr bool PERM = true, AFTER_DRAIN = false;
    bf16_t* O; int ldc; int scale_from; float scale;
    __device__ __forceinline__ void operator()(const f32x4 (&acc)[2][2][4][2], const Unit& u, int wr, int wc, int fr, int fq) const {
        const int row0 = u.pm * BM + wr * 64 + fr, col0 = u.pn * BM + wc * 32 + 8 * fq;
        const float sc = (u.pn * BM >= scale_from) ? scale : 1.f;
#pragma unroll
        for (int ai = 0; ai < 2; ++ai)
#pragma unroll
            for (int m = 0; m < 4; ++m) { bf16_t* rowp = O + (size_t)(row0 + ai * HALF + m * 16) * ldc + col0;
#pragma unroll
                for (int bj = 0; bj < 2; ++bj) { const f32x4 v0 = acc[ai][bj][m][0] * sc, v1 = acc[ai][bj][m][1] * sc;
                    u32x4 w; w.x = cvt_pk_bf16(v0[0], v0[1]); w.y = cvt_pk_bf16(v0[2], v0[3]); w.z = cvt_pk_bf16(v1[0], v1[1]); w.w = cvt_pk_bf16(v1[2], v1[3]);
                    *(u32x4*)(rowp + bj * HALF) = w; } }
    }
};
__device__ __forceinline__ float silu_mul(float g, float up) { return g * __builtin_amdgcn_rcpf(1.f + __builtin_amdgcn_exp2f(-1.4426950408889634f * g)) * up; }
struct EpiSwiglu {
    static constexpr bool PERM = true, AFTER_DRAIN = false;
    bf16_t* Hh; int ldc;
    __device__ __forceinline__ void operator()(const f32x4 (&acc)[2][2][4][2], const Unit& u, int wr, int wc, int fr, int fq) const {
        const int row0 = u.pm * BM + wr * 64 + fr, col0 = u.pn * HALF + wc * 32 + 8 * fq;
#pragma unroll
        for (int ai = 0; ai < 2; ++ai)
#pragma unroll
            for (int m = 0; m < 4; ++m) { bf16_t* rowp = Hh + (size_t)(row0 + ai * HALF + m * 16) * ldc + col0;
                float h[8];
#pragma unroll
                for (int n = 0; n < 2; ++n)
#pragma unroll
                    for (int r = 0; r < 4; ++r) h[4 * n + r] = silu_mul(acc[ai][0][m][n][r], acc[ai][1][m][n][r]);
                u32x4 w; w.x = cvt_pk_bf16(h[0], h[1]); w.y = cvt_pk_bf16(h[2], h[3]); w.z = cvt_pk_bf16(h[4], h[5]); w.w = cvt_pk_bf16(h[6], h[7]);
                *(u32x4*)rowp = w; }
    }
};

template <class Epi, class Sched, bool ALIGN_EPI = false, bool SP2 = false>
__device__ __forceinline__ void gemm_phase(int wv_, PG8_LAS unsigned char* lds, const Gemm g, const Sched& S, const Epi& E) {
    const int wid = wv_, lane = lane_id(), tid = wid * 64 + lane, wr = wid >> 2, wc = wid & 3, fr = lane & 15, fq = lane >> 4;
    const int K = g.K, nt = K / BK;
    unsigned voffA[2], voffB[2];
#pragma unroll
    for (int i = 0; i < 2; ++i) { int R, C; stage_rc(tid * 16 + i * 8192, R, C); const int Rb = Epi::PERM ? ((R & ~31) + perm32(R & 31)) : R;
        voffA[i] = (unsigned)(R * g.lda + C) * 2u; voffB[i] = (unsigned)(Rb * K + C) * 2u; }
    const size_t kstep = (size_t)(BK * 2);
    const size_t hstep = (size_t)HALF * K * 2;
    const size_t tstep = 2 * hstep; const size_t hstepA = (size_t)HALF * g.lda * 2, tstepA = 2 * hstepA;
    const unsigned ldsw = (unsigned)wid * 1024u;
    const int aoff = lds_byte(wr * 64 + fr, fq * 8), boff = lds_byte(wc * 32 + fr, fq * 8);
#define PG8_SA(b, h) (((b) * 2 + (h)) * HTB)
#define PG8_SB(b, h) ((4 + (b) * 2 + (h)) * HTB)
#define PG8_STAGE(bufoff, gbase, voff) do { _Pragma("unroll") for (int _i = 0; _i < 2; ++_i) \
        __builtin_amdgcn_global_load_lds((const unsigned*)((const char*)(gbase) + (voff)[_i]), (PG8_LAS unsigned*)(lds + (bufoff) + ldsw + _i * 8192), 16, 0, 0); } while (0)
#define PG8_LDA(dst, b, h) do { _Pragma("unroll") for (int m = 0; m < 4; ++m) _Pragma("unroll") for (int k = 0; k < 2; ++k) dst[m][k] = *(const PG8_LAS bf16x8*)(lds + PG8_SA(b, h) + aoff + m * 2048 + k * 1024); } while (0)
#define PG8_LDB(dst, b, h) do { _Pragma("unroll") for (int n = 0; n < 2; ++n) _Pragma("unroll") for (int k = 0; k < 2; ++k) dst[n][k] = *(const PG8_LAS bf16x8*)(lds + PG8_SB(b, h) + boff + n * 2048 + k * 1024); } while (0)
#define PG8_MMA(ai, bj, At, Bt) do { __builtin_amdgcn_s_setprio(1); _Pragma("unroll") for (int m = 0; m < 4; ++m) _Pragma("unroll") for (int n = 0; n < 2; ++n) _Pragma("unroll") for (int k = 0; k < 2; ++k) \
        acc[ai][bj][m][n] = __builtin_amdgcn_mfma_f32_16x16x32_bf16(Bt[n][k], At[m][k], acc[ai][bj][m][n], 0, 0, 0); __builtin_amdgcn_s_setprio(0); } while (0)
#define PG8_WAIT_V(n) asm volatile("s_waitcnt vmcnt(" #n ")" ::: "memory")
#define PG8_WAIT_L(n) asm volatile("s_waitcnt lgkmcnt(" #n ")" ::: "memory")
#define PG8_BAR __builtin_amdgcn_s_barrier()
#define PG8_SCHED __builtin_amdgcn_sched_barrier(0)
    Unit cur, nxt; int ui = 0;
    if (!S.next(0, cur)) return;
    f32x4 acc[2][2][4][2];
#pragma unroll
    for (int a = 0; a < 2; ++a)
#pragma unroll
        for (int b = 0; b < 2; ++b)
#pragma unroll
            for (int m = 0; m < 4; ++m)
#pragma unroll
                for (int n = 0; n < 2; ++n) acc[a][b][m][n] = (f32x4){0.f, 0.f, 0.f, 0.f};
    bf16x8 At[4][2], B0[2][2], B1[2][2];
    const char* cA = (const char*)g.A + (size_t)cur.pm * tstepA; const char* cB = (const char*)g.Bt + (size_t)cur.pn * tstep;
    S.a_ready(cur);
    if constexpr (SP2) {
        PG8_STAGE(PG8_SB(0, 0), cB, voffB); PG8_STAGE(PG8_SB(0, 1), cB + hstep, voffB); PG8_STAGE(PG8_SA(0, 0), cA, voffA); PG8_STAGE(PG8_SA(0, 1), cA + hstepA, voffA);
        if (wr == 1) PG8_BAR;
        PG8_WAIT_V(2); PG8_BAR;
        PG8_STAGE(PG8_SB(1, 0), cB + kstep, voffB); PG8_STAGE(PG8_SA(1, 0), cA + kstep, voffA); PG8_STAGE(PG8_SB(1, 1), cB + hstep + kstep, voffB);
        PG8_WAIT_V(6); PG8_BAR;
    } else {
        PG8_STAGE(PG8_SB(0, 0), cB, voffB); PG8_STAGE(PG8_SA(0, 0), cA, voffA); PG8_STAGE(PG8_SB(0, 1), cB + hstep, voffB); PG8_STAGE(PG8_SA(0, 1), cA + hstepA, voffA);
        if (wr == 1) PG8_BAR;
        PG8_WAIT_V(4); PG8_BAR;
        PG8_STAGE(PG8_SB(1, 0), cB + kstep, voffB); PG8_STAGE(PG8_SA(1, 0), cA + kstep, voffA); PG8_STAGE(PG8_SB(1, 1), cB + hstep + kstep, voffB);
        PG8_WAIT_V(6); PG8_BAR;
    }
    for (;;) {
        const bool has_next = S.next(ui + 1, nxt);
        const char* nA = has_next ? (const char*)g.A + (size_t)nxt.pm * tstepA : cA; const char* nB = has_next ? (const char*)g.Bt + (size_t)nxt.pn * tstep : cB;
        for (int t = 0; t < nt; t += 2) {
            const bool last = (t == nt - 2);
            const char* a1 = cA + (size_t)(t + 1) * kstep;
            const char* a2 = last ? nA : cA + (size_t)(t + 2) * kstep; const char* b2 = last ? nB : cB + (size_t)(t + 2) * kstep;
            const char* a3 = a2 + kstep; const char* b3 = b2 + kstep;
            if (last && has_next) S.a_ready(nxt);
            if constexpr (SP2) {
            PG8_LDB(B0, 0, 0); PG8_LDB(B1, 0, 1); PG8_SCHED; PG8_LDA(At, 0, 0); PG8_STAGE(PG8_SA(1, 1), a1 + hstepA, voffA);
            PG8_WAIT_V(8); PG8_WAIT_L(0); PG8_BAR; PG8_MMA(0, 0, At, B0); PG8_MMA(0, 1, At, B1); PG8_BAR; PG8_SCHED;
            PG8_LDA(At, 0, 1); PG8_STAGE(PG8_SB(0, 0), b2, voffB); PG8_STAGE(PG8_SB(0, 1), b2 + hstep, voffB); PG8_STAGE(PG8_SA(0, 0), a2, voffA);
            PG8_WAIT_V(8); PG8_WAIT_L(0); PG8_BAR; PG8_MMA(1, 0, At, B0); PG8_MMA(1, 1, At, B1); PG8_BAR; PG8_SCHED;
            PG8_LDB(B0, 1, 0); PG8_LDB(B1, 1, 1); PG8_SCHED; PG8_LDA(At, 1, 0); PG8_STAGE(PG8_SA(0, 1), a2 + hstepA, voffA);
            PG8_WAIT_V(8); PG8_WAIT_L(0); PG8_BAR; PG8_MMA(0, 0, At, B0); PG8_MMA(0, 1, At, B1); PG8_BAR; PG8_SCHED;
            PG8_LDA(At, 1, 1); PG8_STAGE(PG8_SB(1, 0), b3, voffB); PG8_STAGE(PG8_SB(1, 1), b3 + hstep, voffB); PG8_STAGE(PG8_SA(1, 0), a3, voffA);
            PG8_WAIT_V(8); PG8_WAIT_L(0); PG8_BAR; PG8_MMA(1, 0, At, B0); PG8_MMA(1, 1, At, B1); PG8_BAR; PG8_SCHED;
            } else {
            PG8_LDB(B0, 0, 0); PG8_SCHED; PG8_LDA(At, 0, 0); PG8_STAGE(PG8_SA(1, 1), a1 + hstepA, voffA);
            PG8_WAIT_L(8); PG8_BAR; PG8_WAIT_L(0); PG8_MMA(0, 0, At, B0); PG8_BAR; PG8_SCHED;
            PG8_LDB(B1, 0, 1); PG8_STAGE(PG8_SB(0, 0), b2, voffB);
            PG8_BAR; PG8_WAIT_L(0); PG8_MMA(0, 1, At, B1); PG8_BAR;
            PG8_LDA(At, 0, 1); PG8_STAGE(PG8_SA(0, 0), a2, voffA);
            PG8_BAR; PG8_WAIT_L(0); PG8_MMA(1, 0, At, B0); PG8_BAR; PG8_SCHED;
            PG8_STAGE(PG8_SB(0, 1), b2 + hstep, voffB);
            PG8_WAIT_V(6); PG8_BAR; PG8_MMA(1, 1, At, B1); PG8_BAR;
            PG8_LDB(B0, 1, 0); PG8_SCHED; PG8_LDA(At, 1, 0); PG8_STAGE(PG8_SA(0, 1), a2 + hstepA, voffA);
            PG8_WAIT_L(8); PG8_BAR; PG8_WAIT_L(0); PG8_MMA(0, 0, At, B0); PG8_BAR; PG8_SCHED;
            PG8_LDB(B1, 1, 1); PG8_STAGE(PG8_SB(1, 0), b3, voffB);
            PG8_BAR; PG8_WAIT_L(0); PG8_MMA(0, 1, At, B1); PG8_BAR;
            PG8_LDA(At, 1, 1); PG8_STAGE(PG8_SA(1, 0), a3, voffA);
            PG8_BAR; PG8_WAIT_L(0); PG8_MMA(1, 0, At, B0); PG8_BAR; PG8_SCHED;
            PG8_STAGE(PG8_SB(1, 1), b3 + hstep, voffB);
            PG8_WAIT_V(6); PG8_BAR; PG8_MMA(1, 1, At, B1); PG8_BAR;
            }
        }
        if constexpr (ALIGN_EPI) { if (wr == 0) PG8_BAR; }
        if constexpr (!Epi::AFTER_DRAIN) { E(acc, cur, wr, wc, fr, fq); S.done(cur); }
        if (!has_next) break;
#pragma unroll
        for (int a = 0; a < 2; ++a)
#pragma unroll
            for (int b = 0; b < 2; ++b)
#pragma unroll
                for (int m = 0; m < 4; ++m)
#pragma unroll
                    for (int n = 0; n < 2; ++n) acc[a][b][m][n] = (f32x4){0.f, 0.f, 0.f, 0.f};
        cur = nxt; cA = nA; cB = nB; ++ui;
        if constexpr (ALIGN_EPI) { if (wr == 1) PG8_BAR; }
    }
    PG8_WAIT_V(0);
    if constexpr (!ALIGN_EPI) { if (wr == 0) PG8_BAR; }
    PG8_BAR;
    if constexpr (Epi::AFTER_DRAIN) { E.fused(acc, cur, wr, wc, fr, fq, lds, wid, lane); S.done(cur); }
#undef PG8_SA
#undef PG8_SB
#undef PG8_STAGE
#undef PG8_LDA
#undef PG8_LDB
#undef PG8_MMA
#undef PG8_WAIT_V
#undef PG8_WAIT_L
#undef PG8_BAR
#undef PG8_SCHED
}
}

enum { WM_PLAIN = 0, WM_GU = 1, WM_WA = 2, WM_WUQ = 3 };
__device__ __forceinline__ int src_col(int mode, int n, int nsrc, int& which) {
    which = 0;
    if (mode == WM_PLAIN) return n < nsrc ? n : -1;
    if (mode == WM_GU) { const int G = 128; const int pn = n / (2 * G), r = n % (2 * G); which = r / G; return G * pn + (r % G); }
    if (mode == WM_WA) { if (n < 640) return n; if (n < 704) { const int j = n - 640; return 640 + (j >> 1) + 32 * (j & 1); } return -1; }
      { const int h = n / 192, d = n % 192; if (d < 128) return n; const int j = d - 128; return 192 * h + 128 + (j >> 1) + 32 * (j & 1); }
}
__device__ __forceinline__ void ph_wconv(int wv, char* lds, const float* W0, const float* W1, const float* g, int K, int Nsrc, int Nout, bf16_t* Wt, int mode) {
    const int tid_ = TID_FROM(wv), half = tid_ >> 8, t = tid_ & 255, tx = t & 31, ty = t >> 5;
    float (*tile)[33] = (float (*)[33])(lds + half * 8192);
    const int nbx = Nout / 32, ntiles = nbx * (K / 32);
    for (int tp = blockIdx.x; tp < ntiles / 2; tp += gridDim.x) {
        const int ti = 2 * tp + half, n0 = (ti % nbx) * 32, k0 = (ti / nbx) * 32;
        int which; const int sc = src_col(mode, n0 + tx, Nsrc, which);
        const float* W = which ? W1 : W0;
        __syncthreads();
#pragma unroll
        for (int i = 0; i < 4; ++i) { const int k = k0 + ty + 8 * i; float v = 0.f; if (sc >= 0) { v = W[(size_t)k * Nsrc + sc]; if (g) v *= g[k]; } tile[ty + 8 * i][tx] = v; }
        __syncthreads();
#pragma unroll
        for (int i = 0; i < 4; ++i) { const int n = n0 + ty + 8 * i; Wt[(size_t)n * K + k0 + tx] = (bf16_t)f2bf(tile[tx][ty + 8 * i]); }
    }
}
__device__ __forceinline__ void ph_rope_table(int wv, const int* pos, float* cosT, float* sinT) {
    for (int idx = blockIdx.x * NTHR + TID_FROM(wv); idx < T * 32; idx += gridDim.x * NTHR) {
        const int t = idx >> 5, i = idx & 31;
        const float inv = 1.0f / powf(10000.0f, (float)(2 * i) / 64.0f);
        const float ang = (float)pos[t] * inv;
        float s, c; sincosf(ang, &s, &c);
        cosT[idx] = c; sinT[idx] = s;
    }
}
__device__ __forceinline__ void ph_rows_pre(int wv, const float* x, bf16_t* XN) {
    const int lane = lane_id();
    for (int row = blockIdx.x * NWAVE + wv; row < T; row += gridDim.x * NWAVE) {
        const f32x4* xr = (const f32x4*)(x + (size_t)row * D) + lane;
        f32x4 v[4]; float s = 0.f;
#pragma unroll
        for (int j = 0; j < 4; ++j) { v[j] = xr[64 * j]; s += v[j].x * v[j].x + v[j].y * v[j].y + v[j].z * v[j].z + v[j].w * v[j].w; }
        const float rstd = rsqrtf(wave_sum(s) * (1.f / D) + EPS);
        u32x2* o = (u32x2*)(XN + (size_t)row * D) + lane;
#pragma unroll
        for (int j = 0; j < 4; ++j) { u32x2 w; w.x = pk2(v[j].x * rstd, v[j].y * rstd); w.y = pk2(v[j].z * rstd, v[j].w * rstd); o[64 * j] = w; }
    }
}
__device__ __forceinline__ void ph_rows_post(int wv, const float* xin, const float* Y, const float* g, float* xout, bf16_t* XN) {
    const int lane = lane_id();
    for (int row = blockIdx.x * NWAVE + wv; row < T; row += gridDim.x * NWAVE) {
        const f32x4* yr = (const f32x4*)(Y + (size_t)row * D) + lane;
        const f32x4* xr = (const f32x4*)(xin + (size_t)row * D) + lane;
        const f32x4* gr = (const f32x4*)g + lane;
        f32x4 y[4]; float s = 0.f;
#pragma unroll
        for (int j = 0; j < 4; ++j) { y[j] = yr[64 * j]; s += y[j].x * y[j].x + y[j].y * y[j].y + y[j].z * y[j].z + y[j].w * y[j].w; }
        const float rstd = rsqrtf(wave_sum(s) * (1.f / D) + EPS);
        float s2 = 0.f;
#pragma unroll
        for (int j = 0; j < 4; ++j) { const f32x4 xv = xr[64 * j], gv = gr[64 * j]; y[j] = xv + y[j] * rstd * gv; s2 += y[j].x * y[j].x + y[j].y * y[j].y + y[j].z * y[j].z + y[j].w * y[j].w; }
        f32x4* xo = (f32x4*)(xout + (size_t)row * D) + lane;
#pragma unroll
        for (int j = 0; j < 4; ++j) xo[64 * j] = y[j];
        if (XN) {
            const float r2 = rsqrtf(wave_sum(s2) * (1.f / D) + EPS);
            u32x2* o = (u32x2*)(XN + (size_t)row * D) + lane;
#pragma unroll
            for (int j = 0; j < 4; ++j) { u32x2 w; w.x = pk2(y[j].x * r2, y[j].y * r2); w.y = pk2(y[j].z * r2, y[j].w * r2); o[64 * j] = w; }
        }
    }
}
__device__ __forceinline__ void ph_lat_post(int wv, bf16_t* A, const float* cosT, const float* sinT, bf16_t* KR) {
    const int lane = lane_id();
    for (int row = blockIdx.x * NWAVE + wv; row < T; row += gridDim.x * NWAVE) {
        bf16_t* a = A + (size_t)row * NA;
        float q[6], kv[4]; float sq = 0.f, sk = 0.f;
#pragma unroll
        for (int j = 0; j < 6; ++j) { q[j] = bf2f(a[lane + 64 * j]); sq += q[j] * q[j]; }
#pragma unroll
        for (int j = 0; j < 4; ++j) { kv[j] = bf2f(a[QL + lane + 64 * j]); sk += kv[j] * kv[j]; }
        const float rq = rsqrtf(wave_sum(sq) * (1.f / QL) + EPS), rk = rsqrtf(wave_sum(sk) * (1.f / KVL) + EPS);
#pragma unroll
        for (int j = 0; j < 6; ++j) a[lane + 64 * j] = (bf16_t)f2bf(q[j] * rq);
#pragma unroll
        for (int j = 0; j < 4; ++j) a[QL + lane + 64 * j] = (bf16_t)f2bf(kv[j] * rk);
        if (lane < 32) {
            const float t1 = bf2f(a[640 + 2 * lane]), t2 = bf2f(a[640 + 2 * lane + 1]);
            const float c = cosT[row * 32 + lane], s = sinT[row * 32 + lane];
            KR[(size_t)row * 64 + 2 * lane] = (bf16_t)f2bf(t1 * c - t2 * s);
            KR[(size_t)row * 64 + 2 * lane + 1] = (bf16_t)f2bf(t2 * c + t1 * s);
        }
    }
}
__device__ __forceinline__ void ph_rope_q(int wv, bf16_t* Q, const float* cosT, const float* sinT) {
    for (int idx = blockIdx.x * NTHR + TID_FROM(wv); idx < T * MH * 32; idx += gridDim.x * NTHR) {
        const int i = idx & 31, h = (idx >> 5) & 7, row = idx >> 8;
        bf16_t* p = Q + (size_t)row * NQ + h * 192 + 128 + 2 * i;
        const float t1 = bf2f(p[0]), t2 = bf2f(p[1]), c = cosT[row * 32 + i], s = sinT[row * 32 + i];
        p[0] = (bf16_t)f2bf(t1 * c - t2 * s); p[1] = (bf16_t)f2bf(t2 * c + t1 * s);
    }
}

namespace att {
using s16x4 = __attribute__((ext_vector_type(4))) short;
using f32x16 = __attribute__((ext_vector_type(16))) float;
#define SBAR() __builtin_amdgcn_sched_barrier(0)
template <int MODE> struct AC;
template <> struct AC<0> { static constexpr int NKS = 12, RB = 384, DV = 128, NDB = 4, KBYTES = 64 * 384, VBYTES = 64 * 128 * 2; static constexpr float SCALE = 0.07216878364870322f; };
template <> struct AC<1> { static constexpr int NKS = 4, RB = 128, DV = 64, NDB = 2, KBYTES = 64 * 128, VBYTES = 64 * 64 * 2; static constexpr float SCALE = 0.125f; };
constexpr float THR = 8.f;
__device__ __forceinline__ int crow(int r, int hi) { return (r & 3) + 8 * (r >> 2) + 4 * hi; }
__device__ __forceinline__ unsigned cvtpk(float lo, float hi) { unsigned r; asm volatile("v_cvt_pk_bf16_f32 %0, %1, %2" : "=v"(r) : "v"(lo), "v"(hi)); return r; }
template <int RB> __device__ __forceinline__ int kswz(int row, int colB) { return row * RB + (colB ^ ((row & 7) << 4)); }
template <int NDB> __device__ __forceinline__ int v_st(int k, int c) { const int kk = (k & ~0xC) | ((k & 4) << 1) | ((k & 8) >> 1); return ((kk >> 3) * NDB + (c >> 5)) * 512 + ((kk & 7) * 32 + (c & 31)) * 2; }
__device__ __forceinline__ int v_rd_base(int lane) { return ((lane & 3) << 3) | (((lane >> 2) & 3) << 6) | (((lane >> 4) & 1) << 5) | (((lane >> 5) & 1) << 8); }
template <int NDB> constexpr int v_rd_off(int d0, int ks, int half) { return d0 * 512 + ks * (NDB * 1024) + half * (NDB * 512); }
template <int OFF> __device__ __forceinline__ s16x4 tr_read(int vb) { s16x4 r; asm volatile("ds_read_b64_tr_b16 %0, %1 offset:%2" : "=&v"(r) : "v"(vb), "i"(OFF) : "memory"); return r; }

template <int MODE> __device__ __forceinline__ void partialSM(f32x16& p0, f32x16& p1, float& m_reg, float& alpha) {
    constexpr float SC = AC<MODE>::SCALE, C = SC * 1.4426950408889634f;
    float pmax = p0[0];
#pragma unroll
    for (int r = 1; r < 16; ++r) pmax = fmaxf(pmax, p0[r]);
#pragma unroll
    for (int r = 0; r < 16; ++r) pmax = fmaxf(pmax, p1[r]);
    { auto rr = __builtin_amdgcn_permlane32_swap(__float_as_uint(pmax), __float_as_uint(pmax), false, false); pmax = fmaxf(__uint_as_float(rr[0]), __uint_as_float(rr[1])); }
    float mn;
    if (__builtin_expect(__all(pmax - m_reg <= THR / SC), 1)) { mn = m_reg; alpha = 1.f; }
    else { mn = fmaxf(m_reg, pmax); alpha = __builtin_amdgcn_exp2f((m_reg - mn) * C); m_reg = mn; }
    const float mnC = -mn * C;
#pragma unroll
    for (int r = 0; r < 16; ++r) p0[r] = fmaf(p0[r], C, mnC);
#pragma unroll
    for (int r = 0; r < 16; ++r) p1[r] = fmaf(p1[r], C, mnC);
#pragma unroll
    for (int r = 0; r < 16; ++r) p0[r] = __builtin_amdgcn_exp2f(p0[r]);
}
__device__ __forceinline__ void finishSM(f32x16& p0, f32x16& p1, float alpha, float& l_reg, bf16x8& pa0, bf16x8& pa1, bf16x8& pa2, bf16x8& pa3) {
#pragma unroll
    for (int r = 0; r < 16; ++r) p1[r] = __builtin_amdgcn_exp2f(p1[r]);
    float ps = 0;
#pragma unroll
    for (int r = 0; r < 16; ++r) ps += p0[r];
#pragma unroll
    for (int r = 0; r < 16; ++r) ps += p1[r];
    { auto rr = __builtin_amdgcn_permlane32_swap(__float_as_uint(ps), __float_as_uint(ps), false, false); ps = __uint_as_float(rr[0]) + __uint_as_float(rr[1]); }
    l_reg = l_reg * alpha + ps;
#define PK4(P, BASE, OUT) do { unsigned a0 = cvtpk(P[BASE + 0], P[BASE + 1]), a1 = cvtpk(P[BASE + 2], P[BASE + 3]);   \
    unsigned b0 = cvtpk(P[BASE + 4], P[BASE + 5]), b1 = cvtpk(P[BASE + 6], P[BASE + 7]);                              \
    auto r0 = __builtin_amdgcn_permlane32_swap(a0, b0, false, false); auto r1 = __builtin_amdgcn_permlane32_swap(a1, b1, false, false); \
    u32x4 w = {r0[0], r1[0], r0[1], r1[1]}; OUT = *reinterpret_cast<bf16x8*>(&w); } while (0)
    PK4(p0, 0, pa0); PK4(p0, 8, pa1); PK4(p1, 0, pa2); PK4(p1, 8, pa3);
#undef PK4
}
template <int MODE> __device__ __forceinline__ void qkt(f32x16& p0, f32x16& p1, const char* const (&kb4)[4], int bufoff, const bf16x8* qr) {
    constexpr int NKS = AC<MODE>::NKS, RB = AC<MODE>::RB;
#pragma unroll
    for (int d0 = 0; d0 < NKS; ++d0) { const int e = d0 & 3, g = d0 >> 2;
        const bf16x8 b0 = *reinterpret_cast<const bf16x8*>(kb4[e] + bufoff + g * 128);
        const bf16x8 b1 = *reinterpret_cast<const bf16x8*>(kb4[e] + bufoff + g * 128 + 32 * RB);
        p0 = __builtin_amdgcn_mfma_f32_32x32x16_bf16(b0, qr[d0], p0, 0, 0, 0);
        p1 = __builtin_amdgcn_mfma_f32_32x32x16_bf16(b1, qr[d0], p1, 0, 0, 0);
        if constexpr (NKS > 4) { if ((d0 & 3) == 3 && d0 + 1 < NKS) SBAR(); } }
}
template <int D0, int NDB> __device__ __forceinline__ void pv_one(f32x16& od, int vb, bf16x8 pa0, bf16x8 pa1, bf16x8 pa2, bf16x8 pa3) {
    const s16x4 l0 = tr_read<v_rd_off<NDB>(D0, 0, 0)>(vb), h0 = tr_read<v_rd_off<NDB>(D0, 0, 1)>(vb), l1 = tr_read<v_rd_off<NDB>(D0, 1, 0)>(vb), h1 = tr_read<v_rd_off<NDB>(D0, 1, 1)>(vb);
    const s16x4 l2 = tr_read<v_rd_off<NDB>(D0, 2, 0)>(vb), h2 = tr_read<v_rd_off<NDB>(D0, 2, 1)>(vb), l3 = tr_read<v_rd_off<NDB>(D0, 3, 0)>(vb), h3 = tr_read<v_rd_off<NDB>(D0, 3, 1)>(vb);
    asm volatile("s_waitcnt lgkmcnt(0)" ::: "memory"); SBAR();
#define PK(L, H) (bf16x8){L[0], L[1], L[2], L[3], H[0], H[1], H[2], H[3]}
    od = __builtin_amdgcn_mfma_f32_32x32x16_bf16(pa0, PK(l0, h0), od, 0, 0, 0);
    od = __builtin_amdgcn_mfma_f32_32x32x16_bf16(pa1, PK(l1, h1), od, 0, 0, 0);
    od = __builtin_amdgcn_mfma_f32_32x32x16_bf16(pa2, PK(l2, h2), od, 0, 0, 0);
    od = __builtin_amdgcn_mfma_f32_32x32x16_bf16(pa3, PK(l3, h3), od, 0, 0, 0);
#undef PK
}
template <int NDB> __device__ __forceinline__ void pv_all(f32x16* o, int vb, bf16x8 pa0, bf16x8 pa1, bf16x8 pa2, bf16x8 pa3) {
    pv_one<0, NDB>(o[0], vb, pa0, pa1, pa2, pa3); pv_one<1, NDB>(o[1], vb, pa0, pa1, pa2, pa3);
    if constexpr (NDB == 4) { pv_one<2, NDB>(o[2], vb, pa0, pa1, pa2, pa3); pv_one<3, NDB>(o[3], vb, pa0, pa1, pa2, pa3); }
}

struct Stg0 { u32x4 vs0, vs1, ks0, ks1, kr; };
struct Stg1 { u32x4 vs0, ks0; };

template <int MODE>
__device__ __forceinline__ void attn_unit(int wv, char* lds, const bf16_t* __restrict__ Qp, const bf16_t* __restrict__ Kp, const bf16_t* __restrict__ Vp, const bf16_t* __restrict__ KRp,
                                          bf16_t* __restrict__ Op, const float* __restrict__ relh, int b, int h, int u) {
    using C = AC<MODE>;
    constexpr int NKS = C::NKS, RB = C::RB, DV = C::DV, NDB = C::NDB, KBYTES = C::KBYTES, VBYTES = C::VBYTES;
    constexpr int QPITCH = MODE == 0 ? 1536 : 3072, KPITCH = MODE == 0 ? 2048 : 3072;
    int tid_ = TID_FROM(wv); asm volatile("" : "+v"(tid_));
    const int tid = tid_, wid = wv, lane = tid & 63, r32 = lane & 31, hi = lane >> 5;
    char* V_lds = lds; char* K_lds = lds + 2 * VBYTES;
    float* wsf = (float*)(lds + 2 * VBYTES + 2 * KBYTES) + wid * 64; float* li_l = wsf; float* al_l = wsf + 32;
    float* relT = (float*)(lds + 2 * VBYTES + 2 * KBYTES + 2048);
    const size_t rowbase = (size_t)b * SEQ; const int q0 = 256 * u;
    const int cw = 4 * u + (wid >> 1);
    const int t0 = MODE == 1 ? (4 * u - 8 < 0 ? 0 : 4 * u - 8) : 0;
    const int NT = 4 * u + 4 - t0;
    const int qcol = MODE == 0 ? 192 * h : 2048 + 64 * h, kcol = MODE == 0 ? 256 * h : 64 * h, vcol = MODE == 0 ? 256 * h + 128 : 1024 + 64 * h, ocol = MODE == 0 ? 128 * h : 64 * h;
    float m_reg = -1e30f, l_reg = 0.f; f32x16 o[NDB]; bf16x8 qr[NKS];
#pragma unroll
    for (int d = 0; d < NDB; ++d) o[d] = f32x16{};
    {   const bf16_t* Qw = Qp + (rowbase + q0 + wid * 32 + r32) * QPITCH + qcol + hi * 8;
#pragma unroll
        for (int d0 = 0; d0 < NKS; ++d0) qr[d0] = *reinterpret_cast<const bf16x8*>(Qw + d0 * 16); }
    if constexpr (MODE == 1) { for (int e = tid; e < RELT; e += NTHR) relT[e] = relh[e] * 8.f; }
    const int vb0 = (int)(uintptr_t)V_lds + v_rd_base(lane);
    const char* kb4[4];
#pragma unroll
    for (int e = 0; e < 4; ++e) kb4[e] = K_lds + r32 * RB + (((hi ^ (r32 & 1)) << 4) | ((e ^ ((r32 >> 1) & 3)) << 5));
    const bf16_t* Kh = Kp + rowbase * KPITCH + kcol; const bf16_t* Vh = Vp + rowbase * KPITCH + vcol;
    const int sr = tid >> 4, sc = (tid & 15) * 8;
    const int rr_ = tid >> 3, rc = (tid & 7) * 8;
    typename std::conditional<MODE == 0, Stg0, Stg1>::type st;
#define SLOAD(key0) do { if constexpr (MODE == 0) { \
        st.vs0 = *(const u32x4*)(Vh + (size_t)((key0) + sr) * KPITCH + sc); st.vs1 = *(const u32x4*)(Vh + (size_t)((key0) + 32 + sr) * KPITCH + sc); \
        st.ks0 = *(const u32x4*)(Kh + (size_t)((key0) + sr) * KPITCH + sc); st.ks1 = *(const u32x4*)(Kh + (size_t)((key0) + 32 + sr) * KPITCH + sc); \
        st.kr = *(const u32x4*)(KRp + (rowbase + (key0) + rr_) * 64 + rc); \
    } else { st.vs0 = *(const u32x4*)(Vh + (size_t)((key0) + rr_) * KPITCH + rc); st.ks0 = *(const u32x4*)(Kh + (size_t)((key0) + rr_) * KPITCH + rc); } } while (0)
#define SWRITE(bf) do { if constexpr (MODE == 0) { \
        *(u32x4*)(V_lds + (bf) * VBYTES + v_st<NDB>(sr, sc)) = st.vs0; *(u32x4*)(V_lds + (bf) * VBYTES + v_st<NDB>(32 + sr, sc)) = st.vs1; \
        *(u32x4*)(K_lds + (bf) * KBYTES + kswz<RB>(sr, sc * 2)) = st.ks0; *(u32x4*)(K_lds + (bf) * KBYTES + kswz<RB>(32 + sr, sc * 2)) = st.ks1; \
        *(u32x4*)(K_lds + (bf) * KBYTES + kswz<RB>(rr_, 256 + rc * 2)) = st.kr; \
    } else { *(u32x4*)(V_lds + (bf) * VBYTES + v_st<NDB>(rr_, rc)) = st.vs0; *(u32x4*)(K_lds + (bf) * KBYTES + kswz<RB>(rr_, rc * 2)) = st.ks0; } } while (0)
#define RESC(a) do { if (__any((a) < 1.f)) { if (hi == 0) al_l[r32] = (a); asm volatile("s_waitcnt lgkmcnt(0)" ::: "memory"); \
    _Pragma("unroll") for (int d = 0; d < NDB; ++d) _Pragma("unroll") for (int r = 0; r < 16; ++r) o[d][r] *= al_l[crow(r, hi)]; } } while (0)
#define SCORE(P0, P1, j, bf) do { const int tt = t0 + (j); \
        if constexpr (MODE == 1) { const int qs = q0 + wid * 32 + r32, kb = 64 * tt + 4 * hi; \
            _Pragma("unroll") for (int r = 0; r < 16; ++r) { int d0_ = qs - (kb + (r & 3) + 8 * (r >> 2)); int d1_ = d0_ - 32; \
                d0_ = d0_ < -63 ? -63 : (d0_ > 256 ? 256 : d0_); d1_ = d1_ < -63 ? -63 : (d1_ > 256 ? 256 : d1_); P0[r] = relT[d0_ + 63]; P1[r] = relT[d1_ + 63]; } \
        } else { P0 = f32x16{}; P1 = f32x16{}; } \
        qkt<MODE>(P0, P1, kb4, (bf) * KBYTES, qr); \
        const bool vis = MODE == 0 ? (tt <= cw) : (tt <= cw && tt >= cw - 8); \
        if (!vis) { _Pragma("unroll") for (int r = 0; r < 16; ++r) { P0[r] = -INFINITY; P1[r] = -INFINITY; } } } while (0)
    f32x16 pA0, pA1, pB0, pB1; float alA, alB; bf16x8 pa0, pa1, pa2, pa3;
    SLOAD(64 * t0); asm volatile("s_waitcnt vmcnt(0)" ::: "memory"); SWRITE(0); __syncthreads();
    SCORE(pA0, pA1, 0, 0); partialSM<MODE>(pA0, pA1, m_reg, alA);
    SLOAD(64 * (t0 + 1)); asm volatile("s_waitcnt vmcnt(0)" ::: "memory"); SWRITE(1); __syncthreads();
    for (int j = 1; j + 1 < NT; j += 2) {
        SBAR(); SCORE(pB0, pB1, j, 1);
        finishSM(pA0, pA1, alA, l_reg, pa0, pa1, pa2, pa3); SBAR();
        SLOAD(64 * (t0 + j + 1)); SBAR();
        pv_all<NDB>(o, vb0, pa0, pa1, pa2, pa3); partialSM<MODE>(pB0, pB1, m_reg, alB);
        __syncthreads(); SWRITE(0);
        RESC(alB); __syncthreads();
        SBAR(); SCORE(pA0, pA1, j + 1, 0);
        finishSM(pB0, pB1, alB, l_reg, pa0, pa1, pa2, pa3); SBAR();
        SLOAD(64 * (t0 + j + 2)); SBAR();
        pv_all<NDB>(o, vb0 + VBYTES, pa0, pa1, pa2, pa3); partialSM<MODE>(pA0, pA1, m_reg, alA);
        __syncthreads(); SWRITE(1);
        RESC(alA); __syncthreads();
    }
    SBAR(); SCORE(pB0, pB1, NT - 1, 1);
    finishSM(pA0, pA1, alA, l_reg, pa0, pa1, pa2, pa3); SBAR();
    pv_all<NDB>(o, vb0, pa0, pa1, pa2, pa3); partialSM<MODE>(pB0, pB1, m_reg, alB);
    RESC(alB);
    finishSM(pB0, pB1, alB, l_reg, pa0, pa1, pa2, pa3); SBAR();
    pv_all<NDB>(o, vb0 + VBYTES, pa0, pa1, pa2, pa3);
    if (hi == 0) li_l[r32] = l_reg; asm volatile("s_waitcnt lgkmcnt(0)" ::: "memory");
    float rli[16];
#pragma unroll
    for (int r = 0; r < 16; ++r) rli[r] = __builtin_amdgcn_rcpf(li_l[crow(r, hi)]);
    __syncthreads();
    bf16_t* stg = (bf16_t*)(lds + wid * (32 * DV * 2));
#pragma unroll
    for (int r = 0; r < 16; ++r) { const int orow = crow(r, hi);
#pragma unroll
        for (int d0 = 0; d0 < NDB; ++d0) stg[orow * DV + d0 * 32 + r32] = (bf16_t)f2bf(o[d0][r] * rli[r]); }
    asm volatile("s_waitcnt lgkmcnt(0)" ::: "memory");
    bf16_t* Ow = Op + (rowbase + q0 + wid * 32) * D + ocol;
#pragma unroll
    for (int i = 0; i < DV / 16; ++i) { const int id = i * 64 + lane, row = id / (DV / 8), ch = id % (DV / 8);
        *(u32x4*)(Ow + (size_t)row * D + ch * 8) = *(const u32x4*)(stg + row * DV + ch * 8); }
    __syncthreads();
#undef SLOAD
#undef SWRITE
#undef RESC
#undef SCORE
}
#undef SBAR
}

__device__ __forceinline__ void ph_mla_attn_mfma(int wv, char* lds, const bf16_t* Q, const bf16_t* KV, const bf16_t* KR, bf16_t* O) {
    const int G = gridDim.x, bx = blockIdx.x, vcu = (G % 8 == 0) ? (bx % 8) * (G / 8) + bx / 8 : bx;
    for (int p = vcu; p < 256; p += G) {
        const int bh = p >> 3, s = p & 7;
#pragma unroll 1
        for (int i = 0; i < 2; ++i) att::attn_unit<0>(wv, lds, Q, KV, KV, KR, O, nullptr, bh >> 3, bh & 7, i ? s : 15 - s);
    }
}
__device__ __forceinline__ void ph_chunk_attn_mfma(int wv, char* lds, const bf16_t* KVQ, const float* rel, bf16_t* O) {
    const int G = gridDim.x, bx = blockIdx.x, vcu = (G % 8 == 0) ? (bx % 8) * (G / 8) + bx / 8 : bx;
    for (int p = vcu; p < 256; p += G) {
        const int bh = p >> 2, qd = p & 3;
#pragma unroll 1
        for (int i = 3; i >= 0; --i) att::attn_unit<1>(wv, lds, KVQ, KVQ, KVQ, nullptr, O, rel + (bh & 15) * RELT, bh >> 4, bh & 15, qd + 4 * i);
    }
}


template <class Epi> __device__ __forceinline__ void run_gemm(int wv, char* lds, const bf16_t* A, int lda, const bf16_t* Bt, int M, int N, int K, const Epi& E) {
    pg8::Gemm g{A, Bt, M, N, K, lda}; pg8::StaticOrder S; S.init(M, N, (int)gridDim.x, (int)blockIdx.x);
    pg8::gemm_phase<Epi, pg8::StaticOrder, true, true>(wv, (LAS unsigned char*)lds, g, S, E);
}
__global__ void __launch_bounds__(NTHR, 2) mega_fwd(Params P) {
    extern __shared__ __attribute__((aligned(16))) char lds[];
    cg::grid_group grid = cg::this_grid();
    const int wv = __builtin_amdgcn_readfirstlane((int)threadIdx.x >> 6);
    const float* x = P.in[0]; const int* pos = (const int*)P.in[1];
    const float *attn_pre_g = P.in[2], *attn_post_g = P.in[3], *ffn_pre_g = P.in[4], *ffn_post_g = P.in[5];
    const float *w_gate = P.in[6], *w_up = P.in[7], *w_down = P.in[8];
    const float *w_a = P.in[9], *g_q = P.in[10], *w_uq = P.in[11], *g_kv = P.in[12], *w_ukv = P.in[13], *w_o = P.in[14];
    const float *kv_src_g = P.in[15], *w_kvs = P.in[16], *b_w_q = P.in[17], *rel = P.in[18], *b_w_o = P.in[19];
    float* out = P.out; unsigned char* ws = P.ws;
    float *cosT = (float*)(ws + WS_COS), *sinT = (float*)(ws + WS_SIN);
    bf16_t *KR = (bf16_t*)(ws + WS_KR), *XN = (bf16_t*)(ws + WS_XN);
    bf16_t *Wa = (bf16_t*)(ws + W_A), *Wuq = (bf16_t*)(ws + W_UQ), *Wukv = (bf16_t*)(ws + W_UKV), *Wo = (bf16_t*)(ws + W_O);
    bf16_t *Wgu0 = (bf16_t*)(ws + W_GU0), *Wgu1 = (bf16_t*)(ws + W_GU1), *Wd0 = (bf16_t*)(ws + W_D0), *Wd1 = (bf16_t*)(ws + W_D1);
    bf16_t *Wkvq = (bf16_t*)(ws + W_KVQ), *Wbo = (bf16_t*)(ws + W_BO);
    bf16_t* ALAT = (bf16_t*)(ws + WS_ALAT); bf16_t* Q = (bf16_t*)(ws + WS_Q); bf16_t* KV = (bf16_t*)(ws + WS_KV); bf16_t* O = (bf16_t*)(ws + WS_O);
    float* Y0 = (float*)(ws + WS_Y0); bf16_t* H = (bf16_t*)(ws + WS_H); float* YF = (float*)(ws + WS_YF);
    bf16_t* KVQ = (bf16_t*)(ws + WS_KVQ); bf16_t* O1 = (bf16_t*)(ws + WS_O1); float* Y1 = (float*)(ws + WS_Y1);

    ph_wconv(wv, lds, w_a, nullptr, attn_pre_g, D, 704, NA, Wa, WM_WA);
    ph_wconv(wv, lds, w_uq, nullptr, g_q, QL, NQ, NQ, Wuq, WM_WUQ);
    ph_wconv(wv, lds, w_ukv, nullptr, g_kv, KVL, NKV, NKV, Wukv, WM_PLAIN);
    ph_wconv(wv, lds, w_o, nullptr, nullptr, D, D, D, Wo, WM_PLAIN);
    ph_wconv(wv, lds, w_gate, w_up, ffn_pre_g, D, DFF, 2 * DFF, Wgu0, WM_GU);
    ph_wconv(wv, lds, w_down, nullptr, nullptr, DFF, D, D, Wd0, WM_PLAIN);
    ph_wconv(wv, lds, w_gate + (size_t)D * DFF, w_up + (size_t)D * DFF, ffn_pre_g + D, D, DFF, 2 * DFF, Wgu1, WM_GU);
    ph_wconv(wv, lds, w_down + (size_t)DFF * D, nullptr, nullptr, DFF, D, D, Wd1, WM_PLAIN);
    ph_wconv(wv, lds, w_kvs, nullptr, kv_src_g, D, 2048, 2048, Wkvq, WM_PLAIN);
    ph_wconv(wv, lds, b_w_q, nullptr, attn_pre_g + D, D, D, D, Wkvq + (size_t)2048 * D, WM_PLAIN);
    ph_wconv(wv, lds, b_w_o, nullptr, nullptr, D, D, D, Wbo, WM_PLAIN);
    ph_rope_table(wv, pos, cosT, sinT);
    ph_rows_pre(wv, x, XN);
    grid.sync();
    run_gemm(wv, lds, XN, D, Wa, T, NA, D, pg8::EpiBf16{ALAT, NA, 1 << 30, 1.f});
    grid.sync();
    ph_lat_post(wv, ALAT, cosT, sinT, KR);
    grid.sync();
    run_gemm(wv, lds, ALAT, NA, Wuq, T, NQ, QL, pg8::EpiBf16{Q, NQ, 1 << 30, 1.f});
    run_gemm(wv, lds, ALAT + QL, NA, Wukv, T, NKV, KVL, pg8::EpiBf16{KV, NKV, 1 << 30, 1.f});
    grid.sync();
    ph_rope_q(wv, Q, cosT, sinT);
    grid.sync();
    ph_mla_attn_mfma(wv, lds, Q, KV, KR, O);
    grid.sync();
    run_gemm(wv, lds, O, D, Wo, T, D, D, pg8::EpiF32{Y0, D});
    grid.sync();
    ph_rows_post(wv, x, Y0, attn_post_g, out, XN);
    grid.sync();
    run_gemm(wv, lds, XN, D, Wgu0, T, 2 * DFF, D, pg8::EpiSwiglu{H, DFF});
    grid.sync();
    run_gemm(wv, lds, H, DFF, Wd0, T, D, DFF, pg8::EpiF32{YF, D});
    grid.sync();
    ph_rows_post(wv, out, YF, ffn_post_g, out, XN);
    grid.sync();
    run_gemm(wv, lds, XN, D, Wkvq, T, 3072, D, pg8::EpiBf16{KVQ, 3072, 1 << 30, 1.f});
    grid.sync();
    ph_chunk_attn_mfma(wv, lds, KVQ, rel, O1);
    grid.sync();
    run_gemm(wv, lds, O1, D, Wbo, T, D, D, pg8::EpiF32{Y1, D});
    grid.sync();
    ph_rows_post(wv, out, Y1, attn_post_g + D, out, XN);
    grid.sync();
    run_gemm(wv, lds, XN, D, Wgu1, T, 2 * DFF, D, pg8::EpiSwiglu{H, DFF});
    grid.sync();
    run_gemm(wv, lds, H, DFF, Wd1, T, D, DFF, pg8::EpiF32{YF, D});
    grid.sync();
    ph_rows_post(wv, out, YF, ffn_post_g + D, out, nullptr);
}

extern "C" void kernel_launch(void* const* d_in, const int* in_sizes, int n_in, void* d_out, int out_size, void* d_ws, size_t ws_size, hipStream_t stream) {
    static int grid_blocks = 0;
    if (grid_blocks == 0) {
        int dev = 0, cus = 0, per_cu = 0;
        (void)hipGetDevice(&dev);
        (void)hipDeviceGetAttribute(&cus, hipDeviceAttributeMultiprocessorCount, dev);
        if (hipFuncSetAttribute((const void*)mega_fwd, hipFuncAttributeMaxDynamicSharedMemorySize, LDS_BYTES) != hipSuccess) { fprintf(stderr, "hipFuncSetAttribute failed\n"); grid_blocks = -1; return; }
        if (hipOccupancyMaxActiveBlocksPerMultiprocessor(&per_cu, (const void*)mega_fwd, NTHR, LDS_BYTES) != hipSuccess || per_cu < 1) { fprintf(stderr, "occupancy query: %d\n", per_cu); grid_blocks = -1; return; }
        grid_blocks = cus * per_cu;
    }
    if (grid_blocks < 0) return;
    Params p{};
    for (int i = 0; i < 20; ++i) p.in[i] = (const float*)d_in[i];
    p.out = (float*)d_out; p.ws = (unsigned char*)d_ws;
    void* args[] = {&p};
    hipError_t e = hipLaunchCooperativeKernel((const void*)mega_fwd, dim3(grid_blocks), dim3(NTHR), args, LDS_BYTES, stream);
    if (e != hipSuccess) fprintf(stderr, "cooperative launch failed: %s (grid %d)\n", hipGetErrorString(e), grid_blocks);
}
```

```cpp
#include <hip/hip_runtime.h>
#include <hip/hip_cooperative_groups.h>
namespace cg = cooperative_groups;
#include <cstdint>
#include <type_traits>
#include <cstdio>

typedef unsigned short bf16_t;
typedef short bf16x8 __attribute__((ext_vector_type(8)));
typedef float f32x4 __attribute__((ext_vector_type(4)));
typedef unsigned u32x4 __attribute__((ext_vector_type(4)));
typedef unsigned u32x2 __attribute__((ext_vector_type(2)));

constexpr int BATCH = 4, SEQ = 4096, T = BATCH * SEQ, D = 1024, DFF = 2816;
constexpr int QL = 384, KVL = 256, ROPE = 64, NOPE = 128, VD = 128, MH = 8;
constexpr int NA = 768;
constexpr int NQ = MH * (NOPE + ROPE);
constexpr int NKV = MH * (NOPE + VD);
constexpr int BH = 16, BD = 64, RELT = 320;
constexpr float EPS = 1e-6f;

__device__ __forceinline__ unsigned f2bf(float f) { unsigned u = __builtin_bit_cast(unsigned, f); return (u + 0x7fffu + ((u >> 16) & 1u)) >> 16; }
__device__ __forceinline__ unsigned pk2(float lo, float hi) { return f2bf(lo) | (f2bf(hi) << 16); }
__device__ __forceinline__ float bf2f(unsigned short b) { return __builtin_bit_cast(float, (unsigned)b << 16); }
__device__ __forceinline__ float bflo(unsigned w) { return __builtin_bit_cast(float, w << 16); }
__device__ __forceinline__ float bfhi(unsigned w) { return __builtin_bit_cast(float, w & 0xffff0000u); }
__device__ __forceinline__ float wave_sum(float v) {
#pragma unroll
    for (int o = 1; o < 64; o <<= 1) v += __shfl_xor(v, o);
    return v;
}

__device__ __forceinline__ int lane_id() { return (int)__builtin_amdgcn_mbcnt_hi(~0u, __builtin_amdgcn_mbcnt_lo(~0u, 0u)); }
#define TID_FROM(wv) ((wv) * 64 + lane_id())

constexpr size_t MiB = 1u << 20;
constexpr size_t WS_COS = 1 * MiB, WS_SIN = 3 * MiB;
constexpr size_t WS_KR = 6 * MiB;
constexpr size_t WS_W = 8 * MiB;
constexpr size_t W_A = WS_W;
constexpr size_t W_UQ = W_A + (size_t)NA * D * 2;
constexpr size_t W_UKV = W_UQ + (size_t)NQ * QL * 2;
constexpr size_t W_O = W_UKV + (size_t)NKV * KVL * 2;
constexpr size_t W_GU0 = W_O + (size_t)D * D * 2;
constexpr size_t W_D0 = W_GU0 + (size_t)2 * DFF * D * 2;
constexpr size_t W_GU1 = W_D0 + (size_t)D * DFF * 2;
constexpr size_t W_D1 = W_GU1 + (size_t)2 * DFF * D * 2;
constexpr size_t W_KVQ = W_D1 + (size_t)D * DFF * 2;
constexpr size_t W_BO = W_KVQ + (size_t)3072 * D * 2;
constexpr size_t W_END = W_BO + (size_t)D * D * 2;
static_assert(W_END <= 58 * MiB, "weights fit");
constexpr size_t WS_XN = 58 * MiB;
constexpr size_t WS_R = 90 * MiB;
constexpr size_t WS_ALAT = WS_R;
constexpr size_t WS_O = WS_R;
constexpr size_t WS_Q = 122 * MiB;
constexpr size_t WS_KV = 170 * MiB;
constexpr size_t WS_Y0 = 170 * MiB;
constexpr size_t WS_H = WS_R;
constexpr size_t WS_YF = 186 * MiB;
constexpr size_t WS_KVQ = WS_R;
constexpr size_t WS_O1 = 186 * MiB;
constexpr size_t WS_Y1 = WS_R;


#define LAS __attribute__((address_space(3)))
constexpr int NTHR = 512, NWAVE = 8;
constexpr int LDS_BYTES = 163840;

struct Params { const float* in[20]; float* out; unsigned char* ws; };

namespace pg8 {
#define PG8_LAS __attribute__((address_space(3)))
typedef unsigned short bf16_t;
typedef short bf16x8 __attribute__((ext_vector_type(8)));
typedef float f32x4 __attribute__((ext_vector_type(4)));
typedef unsigned u32x4 __attribute__((ext_vector_type(4)));
constexpr int BM = 256, BK = 64, HALF = 128, HTB = HALF * BK * 2  , STAGE_BYTES = 8 * HTB, NXCD = 8, WGM = 8;

__host__ __device__ __forceinline__ int lds_byte(int r, int c) { const int st = (r >> 4) * 2 + (c >> 5), rr = r & 15, cc = c & 31, ob = rr * 64 + cc * 2; return st * 1024 + (ob ^ (((ob >> 9) & 1) << 5)); }
__host__ __device__ __forceinline__ void stage_rc(int b, int& R, int& C) { const int st = b / 1024, sb = b % 1024, swz = sb ^ (((sb >> 9) & 1) << 5); R = (st >> 1) * 16 + swz / 64; C = (st & 1) * 32 + (swz % 64) / 2; }
__host__ __device__ __forceinline__ int perm32(int rho) { const int n = rho >> 4, i = rho & 15; return 8 * (i >> 2) + 4 * n + (i & 3); }

struct Unit { int pm, pn; };
struct Gemm { const bf16_t* A; const bf16_t* Bt; int M, N, K, lda; };

struct StaticOrder {
    int nM, nN, nwg, G, c;
    __host__ __device__ void init(int M, int N, int G_, int c_) { nM = M / BM; nN = N / BM; nwg = nM * nN; G = G_; c = c_; }
    __host__ __device__ bool next(int i, Unit& u) const {
        const long L = (long)i * G + c; if (L >= nwg) return false;
        int wgid = (int)L; { const int q = nwg / NXCD, r = nwg % NXCD, xcd = wgid % NXCD, off = wgid / NXCD; wgid = (xcd < r ? xcd * (q + 1) : r * (q + 1) + (xcd - r) * q) + off; }
        const int nig = WGM * nN, gid = wgid / nig, fm = gid * WGM, gsz = (nM - fm) < WGM ? (nM - fm) : WGM;
        u.pm = fm + ((wgid % nig) % gsz); u.pn = (wgid % nig) / gsz; return true;
    }
    __device__ __forceinline__ void a_ready(const Unit&) const {}
    __device__ __forceinline__ void done(const Unit&) const {}
};

__device__ __forceinline__ unsigned cvt_pk_bf16(float lo, float hi) { unsigned r; asm volatile("v_cvt_pk_bf16_f32 %0, %1, %2" : "=v"(r) : "v"(lo), "v"(hi)); return r; }
typedef float f32x2 __attribute__((ext_vector_type(2)));

struct EpiF32 {
    static constexpr bool PERM = false, AFTER_DRAIN = false;
    float* C; int ldc;
    __device__ __forceinline__ void operator()(const f32x4 (&acc)[2][2][4][2], const Unit& u, int wr, int wc, int fr, int fq) const {
        const int row0 = u.pm * BM + wr * 64 + fr, col0 = u.pn * BM + wc * 32 + 4 * fq;
#pragma unroll
        for (int ai = 0; ai < 2; ++ai)
#pragma unroll
            for (int m = 0; m < 4; ++m) { float* rowp = C + (size_t)(row0 + ai * HALF + m * 16) * ldc + col0;
#pragma unroll
                for (int bj = 0; bj < 2; ++bj)
#pragma unroll
                    for (int n = 0; n < 2; ++n) *(f32x4*)(rowp + bj * HALF + n * 16) = acc[ai][bj][m][n]; }
    }
};
struct EpiBf16 {
    static constexpr bool PERM = true, AFTER_DRAIN = false;
    bf16_t* O; int ldc; int scale_from; float scale;
    __device__ __forceinline__ void operator()(const f32x4 (&acc)[2][2][4][2], const Unit& u, int wr, int wc, int fr, int fq) const {
        const int row0 = u.pm * BM + wr * 64 + fr, col0 = u.pn * BM + wc * 32 + 8 * fq;
        const float sc = (u.pn * BM >= scale_from) ? scale : 1.f;
#pragma unroll
        for (int ai = 0; ai < 2; ++ai)
#pragma unroll
            for (int m = 0; m < 4; ++m) { bf16_t* rowp = O + (size_t)(row0 + ai * HALF + m * 16) * ldc + col0;
#pragma unroll
                for (int bj = 0; bj < 2; ++bj) { const f32x4 v0 = acc[ai][bj][m][0] * sc, v1 = acc[ai][bj][m][1] * sc;
                    u32x4 w; w.x = cvt_pk_bf16(v0[0], v0[1]); w.y = cvt_pk_bf16(v0[2], v0[3]); w.z = cvt_pk_bf16(v1[0], v1[1]); w.w = cvt_pk_bf16(v1[2], v1[3]);
                    *(u32x4*)(rowp + bj * HALF) = w; } }
    }
};
__device__ __forceinline__ float silu_mul(float g, float up) { return g * __builtin_amdgcn_rcpf(1.f + __builtin_amdgcn_exp2f(-1.4426950408889634f * g)) * up; }
struct EpiSwiglu {
    static constexpr bool PERM = true, AFTER_DRAIN = false;
    bf16_t* Hh; int ldc;
    __device__ __forceinline__ void operator()(const f32x4 (&acc)[2][2][4][2], const Unit& u, int wr, int wc, int fr, int fq) const {
        const int row0 = u.pm * BM + wr * 64 + fr, col0 = u.pn * HALF + wc * 32 + 8 * fq;
#pragma unroll
        for (int ai = 0; ai < 2; ++ai)
#pragma unroll
            for (int m = 0; m < 4; ++m) { bf16_t* rowp = Hh + (size_t)(row0 + ai * HALF + m * 16) * ldc + col0;
                float h[8];
#pragma unroll
                for (int n = 0; n < 2; ++n)
#pragma unroll
                    for (int r = 0; r < 4; ++r) h[4 * n + r] = silu_mul(acc[ai][0][m][n][r], acc[ai][1][m][n][r]);
                u32x4 w; w.x = cvt_pk_bf16(h[0], h[1]); w.y = cvt_pk_bf16(h[2], h[3]); w.z = cvt_pk_bf16(h[4], h[5]); w.w = cvt_pk_bf16(h[6], h[7]);
                *(u32x4*)rowp = w; }
    }
};

template <class Epi, class Sched, bool ALIGN_EPI = false, bool SP2 = false>
__device__ __forceinline__ void gemm_phase(int wv_, PG8_LAS unsigned char* lds, const Gemm g, const Sched& S, const Epi& E) {
    const int wid = wv_, lane = lane_id(), tid = wid * 64 + lane, wr = wid >> 2, wc = wid & 3, fr = lane & 15, fq = lane >> 4;
    const int K = g.K, nt = K / BK;
    unsigned voffA[2], voffB[2];
#pragma unroll
    for (int i = 0; i < 2; ++i) { int R, C; stage_rc(tid * 16 + i * 8192, R, C); const int Rb = Epi::PERM ? ((R & ~31) + perm32(R & 31)) : R;
        voffA[i] = (unsigned)(R * g.lda + C) * 2u; voffB[i] = (unsigned)(Rb * K + C) * 2u; }
    const size_t kstep = (size_t)(BK * 2);
    const size_t hstep = (size_t)HALF * K * 2;
    const size_t tstep = 2 * hstep; const size_t hstepA = (size_t)HALF * g.lda * 2, tstepA = 2 * hstepA;
    const unsigned ldsw = (unsigned)wid * 1024u;
    const int aoff = lds_byte(wr * 64 + fr, fq * 8), boff = lds_byte(wc * 32 + fr, fq * 8);
#define PG8_SA(b, h) (((b) * 2 + (h)) * HTB)
#define PG8_SB(b, h) ((4 + (b) * 2 + (h)) * HTB)
#define PG8_STAGE(bufoff, gbase, voff) do { _Pragma("unroll") for (int _i = 0; _i < 2; ++_i) \
        __builtin_amdgcn_global_load_lds((const unsigned*)((const char*)(gbase) + (voff)[_i]), (PG8_LAS unsigned*)(lds + (bufoff) + ldsw + _i * 8192), 16, 0, 0); } while (0)
#define PG8_LDA(dst, b, h) do { _Pragma("unroll") for (int m = 0; m < 4; ++m) _Pragma("unroll") for (int k = 0; k < 2; ++k) dst[m][k] = *(const PG8_LAS bf16x8*)(lds + PG8_SA(b, h) + aoff + m * 2048 + k * 1024); } while (0)
#define PG8_LDB(dst, b, h) do { _Pragma("unroll") for (int n = 0; n < 2; ++n) _Pragma("unroll") for (int k = 0; k < 2; ++k) dst[n][k] = *(const PG8_LAS bf16x8*)(lds + PG8_SB(b, h) + boff + n * 2048 + k * 1024); } while (0)
#define PG8_MMA(ai, bj, At, Bt) do { __builtin_amdgcn_s_setprio(1); _Pragma("unroll") for (int m = 0; m < 4; ++m) _Pragma("unroll") for (int n = 0; n < 2; ++n) _Pragma("unroll") for (int k = 0; k < 2; ++k) \
        acc[ai][bj][m][n] = __builtin_amdgcn_mfma_f32_16x16x32_bf16(Bt[n][k], At[m][k], acc[ai][bj][m][n], 0, 0, 0); __builtin_amdgcn_s_setprio(0); } while (0)
#define PG8_WAIT_V(n) asm volatile("s_waitcnt vmcnt(" #n ")" ::: "memory")
#define PG8_WAIT_L(n) asm volatile("s_waitcnt lgkmcnt(" #n ")" ::: "memory")
#define PG8_BAR __builtin_amdgcn_s_barrier()
#define PG8_SCHED __builtin_amdgcn_sched_barrier(0)
    Unit cur, nxt; int ui = 0;
    if (!S.next(0, cur)) return;
    f32x4 acc[2][2][4][2];
#pragma unroll
    for (int a = 0; a < 2; ++a)
#pragma unroll
        for (int b = 0; b < 2; ++b)
#pragma unroll
            for (int m = 0; m < 4; ++m)
#pragma unroll
                for (int n = 0; n < 2; ++n) acc[a][b][m][n] = (f32x4){0.f, 0.f, 0.f, 0.f};
    bf16x8 At[4][2], B0[2][2], B1[2][2];
    const char* cA = (const char*)g.A + (size_t)cur.pm * tstepA; const char* cB = (const char*)g.Bt + (size_t)cur.pn * tstep;
    S.a_ready(cur);
    if constexpr (SP2) {
        PG8_STAGE(PG8_SB(0, 0), cB, voffB); PG8_STAGE(PG8_SB(0, 1), cB + hstep, voffB); PG8_STAGE(PG8_SA(0, 0), cA, voffA); PG8_STAGE(PG8_SA(0, 1), cA + hstepA, voffA);
        if (wr == 1) PG8_BAR;
        PG8_WAIT_V(2); PG8_BAR;
        PG8_STAGE(PG8_SB(1, 0), cB + kstep, voffB); PG8_STAGE(PG8_SA(1, 0), cA + kstep, voffA); PG8_STAGE(PG8_SB(1, 1), cB + hstep + kstep, voffB);
        PG8_WAIT_V(6); PG8_BAR;
    } else {
        PG8_STAGE(PG8_SB(0, 0), cB, voffB); PG8_STAGE(PG8_SA(0, 0), cA, voffA); PG8_STAGE(PG8_SB(0, 1), cB + hstep, voffB); PG8_STAGE(PG8_SA(0, 1), cA + hstepA, voffA);
        if (wr == 1) PG8_BAR;
        PG8_WAIT_V(4); PG8_BAR;
        PG8_STAGE(PG8_SB(1, 0), cB + kstep, voffB); PG8_STAGE(PG8_SA(1, 0), cA + kstep, voffA); PG8_STAGE(PG8_SB(1, 1), cB + hstep + kstep, voffB);
        PG8_WAIT_V(6); PG8_BAR;
    }
    for (;;) {
        const bool has_next = S.next(ui + 1, nxt);
        const char* nA = has_next ? (const char*)g.A + (size_t)nxt.pm * tstepA : cA; const char* nB = has_next ? (const char*)g.Bt + (size_t)nxt.pn * tstep : cB;
        for (int t = 0; t < nt; t += 2) {
            const bool last = (t == nt - 2);
            const char* a1 = cA + (size_t)(t + 1) * kstep;
            const char* a2 = last ? nA : cA + (size_t)(t + 2) * kstep; const char* b2 = last ? nB : cB + (size_t)(t + 2) * kstep;
            const char* a3 = a2 + kstep; const char* b3 = b2 + kstep;
            if (last && has_next) S.a_ready(nxt);
            if constexpr (SP2) {
            PG8_LDB(B0, 0, 0); PG8_LDB(B1, 0, 1); PG8_SCHED; PG8_LDA(At, 0, 0); PG8_STAGE(PG8_SA(1, 1), a1 + hstepA, voffA);
            PG8_WAIT_V(8); PG8_WAIT_L(0); PG8_BAR; PG8_MMA(0, 0, At, B0); PG8_MMA(0, 1, At, B1); PG8_BAR; PG8_SCHED;
            PG8_LDA(At, 0, 1); PG8_STAGE(PG8_SB(0, 0), b2, voffB); PG8_STAGE(PG8_SB(0, 1), b2 + hstep, voffB); PG8_STAGE(PG8_SA(0, 0), a2, voffA);
            PG8_WAIT_V(8); PG8_WAIT_L(0); PG8_BAR; PG8_MMA(1, 0, At, B0); PG8_MMA(1, 1, At, B1); PG8_BAR; PG8_SCHED;
            PG8_LDB(B0, 1, 0); PG8_LDB(B1, 1, 1); PG8_SCHED; PG8_LDA(At, 1, 0); PG8_STAGE(PG8_SA(0, 1), a2 + hstepA, voffA);
            PG8_WAIT_V(8); PG8_WAIT_L(0); PG8_BAR; PG8_MMA(0, 0, At, B0); PG8_MMA(0, 1, At, B1); PG8_BAR; PG8_SCHED;
            PG8_LDA(At, 1, 1); PG8_STAGE(PG8_SB(1, 0), b3, voffB); PG8_STAGE(PG8_SB(1, 1), b3 + hstep, voffB); PG8_STAGE(PG8_SA(1, 0), a3, voffA);
            PG8_WAIT_V(8); PG8_WAIT_L(0); PG8_BAR; PG8_MMA(1, 0, At, B0); PG8_MMA(1, 1, At, B1); PG8_BAR; PG8_SCHED;
            } else {
            PG8_LDB(B0, 0, 0); PG8_SCHED; PG8_LDA(At, 0, 0); PG8_STAGE(PG8_SA(1, 1), a1 + hstepA, voffA);
            PG8_WAIT_L(8); PG8_BAR; PG8_WAIT_L(0); PG8_MMA(0, 0, At, B0); PG8_BAR; PG8_SCHED;
            PG8_LDB(B1, 0, 1); PG8_STAGE(PG8_SB(0, 0), b2, voffB);
            PG8_BAR; PG8_WAIT_L(0); PG8_MMA(0, 1, At, B1); PG8_BAR;
            PG8_LDA(At, 0, 1); PG8_STAGE(PG8_SA(0, 0), a2, voffA);
            PG8_BAR; PG8_WAIT_L(0); PG8_MMA(1, 0, At, B0); PG8_BAR; PG8_SCHED;
            PG8_STAGE(PG8_SB(0, 1), b2 + hstep, voffB);
            PG8_WAIT_V(6); PG8_BAR; PG8_MMA(1, 1, At, B1); PG8_BAR;
            PG8_LDB(B0, 1, 0); PG8_SCHED; PG8_LDA(At, 1, 0); PG8_STAGE(PG8_SA(0, 1), a2 + hstepA, voffA);
            PG8_WAIT_L(8); PG8_BAR; PG8_WAIT_L(0); PG8_MMA(0, 0, At, B0); PG8_BAR; PG8_SCHED;
            PG8_LDB(B1, 1, 1); PG8_STAGE(PG8_SB(1, 0), b3, voffB);
            PG8_BAR; PG8_WAIT_L(0); PG8_MMA(0, 1, At, B1); PG8_BAR;
            PG8_LDA(At, 1, 1); PG8_STAGE(PG8_SA(1, 0), a3, voffA);
            PG8_BAR; PG8_WAIT_L(0); PG8_MMA(1, 0, At, B0); PG8_BAR; PG8_SCHED;
            PG8_STAGE(PG8_SB(1, 1), b3 + hstep, voffB);
            PG8_WAIT_V(6); PG8_BAR; PG8_MMA(1, 1, At, B1); PG8_BAR;
            }
        }
        if constexpr (ALIGN_EPI) { if (wr == 0) PG8_BAR; }
        if constexpr (!Epi::AFTER_DRAIN) { E(acc, cur, wr, wc, fr, fq); S.done(cur); }
        if (!has_next) break;
#pragma unroll
        for (int a = 0; a < 2; ++a)
#pragma unroll
            for (int b = 0; b < 2; ++b)
#pragma unroll
                for (int m = 0; m < 4; ++m)
#pragma unroll
                    for (int n = 0; n < 2; ++n) acc[a][b][m][n] = (f32x4){0.f, 0.f, 0.f, 0.f};
        cur = nxt; cA = nA; cB = nB; ++ui;
        if constexpr (ALIGN_EPI) { if (wr == 1) PG8_BAR; }
    }
    PG8_WAIT_V(0);
    if constexpr (!ALIGN_EPI) { if (wr == 0) PG8_BAR; }
    PG8_BAR;
    if constexpr (Epi::AFTER_DRAIN) { E.fused(acc, cur, wr, wc, fr, fq, lds, wid, lane); S.done(cur); }
#undef PG8_SA
#undef PG8_SB
#undef PG8_STAGE
#undef PG8_LDA
#undef PG8_LDB
#undef PG8_MMA
#undef PG8_WAIT_V
#undef PG8_WAIT_L
#undef PG8_BAR
#undef PG8_SCHED
}
}

enum { WM_PLAIN = 0, WM_GU = 1, WM_WA = 2, WM_WUQ = 3 };
__device__ __forceinline__ int src_col(int mode, int n, int nsrc, int& which) {
    which = 0;
    if (mode == WM_PLAIN) return n < nsrc ? n : -1;
    if (mode == WM_GU) { const int G = 128; const int pn = n / (2 * G), r = n % (2 * G); which = r / G; return G * pn + (r % G); }
    if (mode == WM_WA) { if (n < 640) return n; if (n < 704) { const int j = n - 640; return 640 + (j >> 1) + 32 * (j & 1); } return -1; }
      { const int h = n / 192, d = n % 192; if (d < 128) return n; const int j = d - 128; return 192 * h + 128 + (j >> 1) + 32 * (j & 1); }
}
__device__ __forceinline__ void ph_wconv(int wv, char* lds, const float* W0, const float* W1, const float* g, int K, int Nsrc, int Nout, bf16_t* Wt, int mode) {
    const int tid_ = TID_FROM(wv), half = tid_ >> 8, t = tid_ & 255, tx = t & 31, ty = t >> 5;
    float (*tile)[33] = (float (*)[33])(lds + half * 8192);
    const int nbx = Nout / 32, ntiles = nbx * (K / 32);
    for (int tp = blockIdx.x; tp < ntiles / 2; tp += gridDim.x) {
        const int ti = 2 * tp + half, n0 = (ti % nbx) * 32, k0 = (ti / nbx) * 32;
        int which; const int sc = src_col(mode, n0 + tx, Nsrc, which);
        const float* W = which ? W1 : W0;
        __syncthreads();
#pragma unroll
        for (int i = 0; i < 4; ++i) { const int k = k0 + ty + 8 * i; float v = 0.f; if (sc >= 0) { v = W[(size_t)k * Nsrc + sc]; if (g) v *= g[k]; } tile[ty + 8 * i][tx] = v; }
        __syncthreads();
#pragma unroll
        for (int i = 0; i < 4; ++i) { const int n = n0 + ty + 8 * i; Wt[(size_t)n * K + k0 + tx] = (bf16_t)f2bf(tile[tx][ty + 8 * i]); }
    }
}
__device__ __forceinline__ void ph_rope_table(int wv, const int* pos, float* cosT, float* sinT) {
    for (int idx = blockIdx.x * NTHR + TID_FROM(wv); idx < T * 32; idx += gridDim.x * NTHR) {
        const int t = idx >> 5, i = idx & 31;
        const float inv = 1.0f / powf(10000.0f, (float)(2 * i) / 64.0f);
        const float ang = (float)pos[t] * inv;
        float s, c; sincosf(ang, &s, &c);
        cosT[idx] = c; sinT[idx] = s;
    }
}
__device__ __forceinline__ void ph_rows_pre(int wv, const float* x, bf16_t* XN) {
    const int lane = lane_id();
    for (int row = blockIdx.x * NWAVE + wv; row < T; row += gridDim.x * NWAVE) {
        const f32x4* xr = (const f32x4*)(x + (size_t)row * D) + lane;
        f32x4 v[4]; float s = 0.f;
#pragma unroll
        for (int j = 0; j < 4; ++j) { v[j] = xr[64 * j]; s += v[j].x * v[j].x + v[j].y * v[j].y + v[j].z * v[j].z + v[j].w * v[j].w; }
        const float rstd = rsqrtf(wave_sum(s) * (1.f / D) + EPS);
        u32x2* o = (u32x2*)(XN + (size_t)row * D) + lane;
#pragma unroll
        for (int j = 0; j < 4; ++j) { u32x2 w; w.x = pk2(v[j].x * rstd, v[j].y * rstd); w.y = pk2(v[j].z * rstd, v[j].w * rstd); o[64 * j] = w; }
    }
}
__device__ __forceinline__ void ph_rows_post(int wv, const float* xin, const float* Y, const float* g, float* xout, bf16_t* XN) {
    const int lane = lane_id();
    for (int row = blockIdx.x * NWAVE + wv; row < T; row += gridDim.x * NWAVE) {
        const f32x4* yr = (const f32x4*)(Y + (size_t)row * D) + lane;
        const f32x4* xr = (const f32x4*)(xin + (size_t)row * D) + lane;
        const f32x4* gr = (const f32x4*)g + lane;
        f32x4 y[4]; float s = 0.f;
#pragma unroll
        for (int j = 0; j < 4; ++j) { y[j] = yr[64 * j]; s += y[j].x * y[j].x + y[j].y * y[j].y + y[j].z * y[j].z + y[j].w * y[j].w; }
        const float rstd = rsqrtf(wave_sum(s) * (1.f / D) + EPS);
        float s2 = 0.f;
#pragma unroll
        for (int j = 0; j < 4; ++j) { const f32x4 xv = xr[64 * j], gv = gr[64 * j]; y[j] = xv + y[j] * rstd * gv; s2 += y[j].x * y[j].x + y[j].y * y[j].y + y[j].z * y[j].z + y[j].w * y[j].w; }
        f32x4* xo = (f32x4*)(xout + (size_t)row * D) + lane;
#pragma unroll
        for (int j = 0; j < 4; ++j) xo[64 * j] = y[j];
        if (XN) {
            const float r2 = rsqrtf(wave_sum(s2) * (1.f / D) + EPS);
            u32x2* o = (u32x2*)(XN + (size_t)row * D) + lane;
#pragma unroll
            for (int j = 0; j < 4; ++j) { u32x2 w; w.x = pk2(y[j].x * r2, y[j].y * r2); w.y = pk2(y[j].z * r2, y[j].w * r2); o[64 * j] = w; }
        }
    }
}
__device__ __forceinline__ void ph_lat_post(int wv, bf16_t* A, const float* cosT, const float* sinT, bf16_t* KR) {
    const int lane = lane_id();
    for (int row = blockIdx.x * NWAVE + wv; row < T; row += gridDim.x * NWAVE) {
        bf16_t* a = A + (size_t)row * NA;
        float q[6], kv[4]; float sq = 0.f, sk = 0.f;
#pragma unroll
        for (int j = 0; j < 6; ++j) { q[j] = bf2f(a[lane + 64 * j]); sq += q[j] * q[j]; }
#pragma unroll
        for (int j = 0; j < 4; ++j) { kv[j] = bf2f(a[QL + lane + 64 * j]); sk += kv[j] * kv[j]; }
        const float rq = rsqrtf(wave_sum(sq) * (1.f / QL) + EPS), rk = rsqrtf(wave_sum(sk) * (1.f / KVL) + EPS);
#pragma unroll
        for (int j = 0; j < 6; ++j) a[lane + 64 * j] = (bf16_t)f2bf(q[j] * rq);
#pragma unroll
        for (int j = 0; j < 4; ++j) a[QL + lane + 64 * j] = (bf16_t)f2bf(kv[j] * rk);
        if (lane < 32) {
            const float t1 = bf2f(a[640 + 2 * lane]), t2 = bf2f(a[640 + 2 * lane + 1]);
            const float c = cosT[row * 32 + lane], s = sinT[row * 32 + lane];
            KR[(size_t)row * 64 + 2 * lane] = (bf16_t)f2bf(t1 * c - t2 * s);
            KR[(size_t)row * 64 + 2 * lane + 1] = (bf16_t)f2bf(t2 * c + t1 * s);
        }
    }
}
__device__ __forceinline__ void ph_rope_q(int wv, bf16_t* Q, const float* cosT, const float* sinT) {
    for (int idx = blockIdx.x * NTHR + TID_FROM(wv); idx < T * MH * 32; idx += gridDim.x * NTHR) {
        const int i = idx & 31, h = (idx >> 5) & 7, row = idx >> 8;
        bf16_t* p = Q + (size_t)row * NQ + h * 192 + 128 + 2 * i;
        const float t1 = bf2f(p[0]), t2 = bf2f(p[1]), c = cosT[row * 32 + i], s = sinT[row * 32 + i];
        p[0] = (bf16_t)f2bf(t1 * c - t2 * s); p[1] = (bf16_t)f2bf(t2 * c + t1 * s);
    }
}

namespace att {
using s16x4 = __attribute__((ext_vector_type(4))) short;
using f32x16 = __attribute__((ext_vector_type(16))) float;
#define SBAR() __builtin_amdgcn_sched_barrier(0)
template <int MODE> struct AC;
template <> struct AC<0> { static constexpr int NQR = 8, NKS = 12, RB = 384, DV = 128, NDB = 4, KBYTES = 64 * 384, VBYTES = 64 * 128 * 2; static constexpr float SCALE = 0.07216878364870322f; };
template <> struct AC<1> { static constexpr int NQR = 4, NKS = 4, RB = 128, DV = 64, NDB = 2, KBYTES = 64 * 128, VBYTES = 64 * 64 * 2; static constexpr float SCALE = 0.125f; };
constexpr float THR = 8.f;
__device__ __forceinline__ int crow(int r, int hi) { return (r & 3) + 8 * (r >> 2) + 4 * hi; }
__device__ __forceinline__ unsigned cvtpk(float lo, float hi) { unsigned r; asm volatile("v_cvt_pk_bf16_f32 %0, %1, %2" : "=v"(r) : "v"(lo), "v"(hi)); return r; }
template <int RB> __device__ __forceinline__ int kswz(int row, int colB) { return row * RB + (colB ^ ((row & 7) << 4)); }
template <int NDB> __device__ __forceinline__ int v_st(int k, int c) { const int kk = (k & ~0xC) | ((k & 4) << 1) | ((k & 8) >> 1); return ((kk >> 3) * NDB + (c >> 5)) * 512 + ((kk & 7) * 32 + (c & 31)) * 2; }
__device__ __forceinline__ int v_rd_base(int lane) { return ((lane & 3) << 3) | (((lane >> 2) & 3) << 6) | (((lane >> 4) & 1) << 5) | (((lane >> 5) & 1) << 8); }
template <int NDB> constexpr int v_rd_off(int d0, int ks, int half) { return d0 * 512 + ks * (NDB * 1024) + half * (NDB * 512); }
template <int OFF> __device__ __forceinline__ s16x4 tr_read(int vb) { s16x4 r; asm volatile("ds_read_b64_tr_b16 %0, %1 offset:%2" : "=&v"(r) : "v"(vb), "i"(OFF) : "memory"); return r; }

template <int MODE> __device__ __forceinline__ void partialSM(f32x16& p0, f32x16& p1, float& m_reg, float& alpha) {
    constexpr float SC = AC<MODE>::SCALE, C = SC * 1.4426950408889634f;
    float pmax = p0[0];
#pragma unroll
    for (int r = 1; r < 16; ++r) pmax = fmaxf(pmax, p0[r]);
#pragma unroll
    for (int r = 0; r < 16; ++r) pmax = fmaxf(pmax, p1[r]);
    { auto rr = __builtin_amdgcn_permlane32_swap(__float_as_uint(pmax), __float_as_uint(pmax), false, false); pmax = fmaxf(__uint_as_float(rr[0]), __uint_as_float(rr[1])); }
    float mn;
    if (__builtin_expect(__all(pmax - m_reg <= THR / SC), 1)) { mn = m_reg; alpha = 1.f; }
    else { mn = fmaxf(m_reg, pmax); alpha = __builtin_amdgcn_exp2f((m_reg - mn) * C); m_reg = mn; }
    const float mnC = -mn * C;
#pragma unroll
    for (int r = 0; r < 16; ++r) p0[r] = fmaf(p0[r], C, mnC);
#pragma unroll
    for (int r = 0; r < 16; ++r) p1[r] = fmaf(p1[r], C, mnC);
#pragma unroll
    for (int r = 0; r < 16; ++r) p0[r] = __builtin_amdgcn_exp2f(p0[r]);
}
__device__ __forceinline__ void finishSM(f32x16& p0, f32x16& p1, float alpha, float& l_reg, bf16x8& pa0, bf16x8& pa1, bf16x8& pa2, bf16x8& pa3) {
#pragma unroll
    for (int r = 0; r < 16; ++r) p1[r] = __builtin_amdgcn_exp2f(p1[r]);
    float ps = 0;
#pragma unroll
    for (int r = 0; r < 16; ++r) ps += p0[r];
#pragma unroll
    for (int r = 0; r < 16; ++r) ps += p1[r];
    { auto rr = __builtin_amdgcn_permlane32_swap(__float_as_uint(ps), __float_as_uint(ps), false, false); ps = __uint_as_float(rr[0]) + __uint_as_float(rr[1]); }
    l_reg = l_reg * alpha + ps;
#define PK4(P, BASE, OUT) do { unsigned a0 = cvtpk(P[BASE + 0], P[BASE + 1]), a1 = cvtpk(P[BASE + 2], P[BASE + 3]);   \
    unsigned b0 = cvtpk(P[BASE + 4], P[BASE + 5]), b1 = cvtpk(P[BASE + 6], P[BASE + 7]);                              \
    auto r0 = __builtin_amdgcn_permlane32_swap(a0, b0, false, false); auto r1 = __builtin_amdgcn_permlane32_swap(a1, b1, false, false); \
    u32x4 w = {r0[0], r1[0], r0[1], r1[1]}; OUT = *reinterpret_cast<bf16x8*>(&w); } while (0)
    PK4(p0, 0, pa0); PK4(p0, 8, pa1); PK4(p1, 0, pa2); PK4(p1, 8, pa3);
#undef PK4
}
template <int MODE> __device__ __forceinline__ void qkt(f32x16& p0, f32x16& p1, const char* const (&kb4)[4], int bufoff, const bf16x8* qr, const char* qlds) {
    constexpr int NKS = AC<MODE>::NKS, RB = AC<MODE>::RB, NQR = AC<MODE>::NQR;
#pragma unroll
    for (int d0 = 0; d0 < NKS; ++d0) { const int e = d0 & 3, g = d0 >> 2;
        const bf16x8 b0 = *reinterpret_cast<const bf16x8*>(kb4[e] + bufoff + g * 128);
        const bf16x8 b1 = *reinterpret_cast<const bf16x8*>(kb4[e] + bufoff + g * 128 + 32 * RB);
        const bf16x8 qf = d0 < NQR ? qr[d0 < NQR ? d0 : 0] : *reinterpret_cast<const bf16x8*>(qlds + (d0 - NQR) * 1024);
        p0 = __builtin_amdgcn_mfma_f32_32x32x16_bf16(b0, qf, p0, 0, 0, 0);
        p1 = __builtin_amdgcn_mfma_f32_32x32x16_bf16(b1, qf, p1, 0, 0, 0);
        if constexpr (NKS > 4) { if ((d0 & 3) == 3 && d0 + 1 < NKS) SBAR(); } }
}
template <int D0, int NDB> __device__ __forceinline__ void pv_one(f32x16& od, int vb, bf16x8 pa0, bf16x8 pa1, bf16x8 pa2, bf16x8 pa3) {
    const s16x4 l0 = tr_read<v_rd_off<NDB>(D0, 0, 0)>(vb), h0 = tr_read<v_rd_off<NDB>(D0, 0, 1)>(vb), l1 = tr_read<v_rd_off<NDB>(D0, 1, 0)>(vb), h1 = tr_read<v_rd_off<NDB>(D0, 1, 1)>(vb);
    const s16x4 l2 = tr_read<v_rd_off<NDB>(D0, 2, 0)>(vb), h2 = tr_read<v_rd_off<NDB>(D0, 2, 1)>(vb), l3 = tr_read<v_rd_off<NDB>(D0, 3, 0)>(vb), h3 = tr_read<v_rd_off<NDB>(D0, 3, 1)>(vb);
    asm volatile("s_waitcnt lgkmcnt(0)" ::: "memory"); SBAR();
#define PK(L, H) (bf16x8){L[0], L[1], L[2], L[3], H[0], H[1], H[2], H[3]}
    od = __builtin_amdgcn_mfma_f32_32x32x16_bf16(pa0, PK(l0, h0), od, 0, 0, 0);
    od = __builtin_amdgcn_mfma_f32_32x32x16_bf16(pa1, PK(l1, h1), od, 0, 0, 0);
    od = __builtin_amdgcn_mfma_f32_32x32x16_bf16(pa2, PK(l2, h2), od, 0, 0, 0);
    od = __builtin_amdgcn_mfma_f32_32x32x16_bf16(pa3, PK(l3, h3), od, 0, 0, 0);
#undef PK
}
template <int NDB> __device__ __forceinline__ void pv_all(f32x16* o, int vb, bf16x8 pa0, bf16x8 pa1, bf16x8 pa2, bf16x8 pa3) {
    pv_one<0, NDB>(o[0], vb, pa0, pa1, pa2, pa3); pv_one<1, NDB>(o[1], vb, pa0, pa1, pa2, pa3);
    if constexpr (NDB == 4) { pv_one<2, NDB>(o[2], vb, pa0, pa1, pa2, pa3); pv_one<3, NDB>(o[3], vb, pa0, pa1, pa2, pa3); }
}

struct Stg0 { u32x4 vs0, vs1, ks0, ks1, kr; };
struct Stg1 { u32x4 vs0, ks0; };

template <int MODE>
__device__ __forceinline__ void attn_unit(int wv, char* lds, const bf16_t* __restrict__ Qp, const bf16_t* __restrict__ Kp, const bf16_t* __restrict__ Vp, const bf16_t* __restrict__ KRp,
                                          bf16_t* __restrict__ Op, const float* __restrict__ relh, int b, int h, int u) {
    using C = AC<MODE>;
    constexpr int NKS = C::NKS, RB = C::RB, DV = C::DV, NDB = C::NDB, KBYTES = C::KBYTES, VBYTES = C::VBYTES;
    constexpr int QPITCH = MODE == 0 ? 1536 : 3072, KPITCH = MODE == 0 ? 2048 : 3072;
    int tid_ = TID_FROM(wv); asm volatile("" : "+v"(tid_));
    const int tid = tid_, wid = wv, lane = tid & 63, r32 = lane & 31, hi = lane >> 5;
    char* V_lds = lds; char* K_lds = lds + 2 * VBYTES;
    float* wsf = (float*)(lds + 2 * VBYTES + 2 * KBYTES) + wid * 64; float* li_l = wsf; float* al_l = wsf + 32;
    float* relT = (float*)(lds + 2 * VBYTES + 2 * KBYTES + 2048);
    const size_t rowbase = (size_t)b * SEQ; const int q0 = 256 * u;
    const int cw = 4 * u + (wid >> 1);
    const int t0 = MODE == 1 ? (4 * u - 8 < 0 ? 0 : 4 * u - 8) : 0;
    const int NT = 4 * u + 4 - t0;
    const int qcol = MODE == 0 ? 192 * h : 2048 + 64 * h, kcol = MODE == 0 ? 256 * h : 64 * h, vcol = MODE == 0 ? 256 * h + 128 : 1024 + 64 * h, ocol = MODE == 0 ? 128 * h : 64 * h;
    constexpr int NQR = C::NQR;
    float m_reg = -1e30f, l_reg = 0.f; f32x16 o[NDB]; bf16x8 qr[NQR];
    char* qlds = lds + 2 * VBYTES + 2 * KBYTES + 4096 + wid * 4096 + lane * 16;
#pragma unroll
    for (int d = 0; d < NDB; ++d) o[d] = f32x16{};
    {   const bf16_t* Qw = Qp + (rowbase + q0 + wid * 32 + r32) * QPITCH + qcol + hi * 8;
#pragma unroll
        for (int d0 = 0; d0 < NQR; ++d0) qr[d0] = *reinterpret_cast<const bf16x8*>(Qw + d0 * 16);
#pragma unroll
        for (int d0 = NQR; d0 < NKS; ++d0) *reinterpret_cast<bf16x8*>(qlds + (d0 - NQR) * 1024) = *reinterpret_cast<const bf16x8*>(Qw + d0 * 16); }
    if constexpr (MODE == 1) { for (int e = tid; e < RELT; e += NTHR) relT[e] = relh[e] * 8.f; }
    const int vb0 = (int)(uintptr_t)V_lds + v_rd_base(lane);
    const char* kb4[4];
#pragma unroll
    for (int e = 0; e < 4; ++e) kb4[e] = K_lds + r32 * RB + (((hi ^ (r32 & 1)) << 4) | ((e ^ ((r32 >> 1) & 3)) << 5));
    const bf16_t* Kh = Kp + rowbase * KPITCH + kcol; const bf16_t* Vh = Vp + rowbase * KPITCH + vcol;
    const int sr = tid >> 4, sc = (tid & 15) * 8;
    const int rr_ = tid >> 3, rc = (tid & 7) * 8;
    typename std::conditional<MODE == 0, Stg0, Stg1>::type st;
#define SLOAD(key0) do { if constexpr (MODE == 0) { \
        st.vs0 = *(const u32x4*)(Vh + (size_t)((key0) + sr) * KPITCH + sc); st.vs1 = *(const u32x4*)(Vh + (size_t)((key0) + 32 + sr) * KPITCH + sc); \
        st.ks0 = *(const u32x4*)(Kh + (size_t)((key0) + sr) * KPITCH + sc); st.ks1 = *(const u32x4*)(Kh + (size_t)((key0) + 32 + sr) * KPITCH + sc); \
        st.kr = *(const u32x4*)(KRp + (rowbase + (key0) + rr_) * 64 + rc); \
    } else { st.vs0 = *(const u32x4*)(Vh + (size_t)((key0) + rr_) * KPITCH + rc); st.ks0 = *(const u32x4*)(Kh + (size_t)((key0) + rr_) * KPITCH + rc); } } while (0)
#define SWRITE(bf) do { if constexpr (MODE == 0) { \
        *(u32x4*)(V_lds + (bf) * VBYTES + v_st<NDB>(sr, sc)) = st.vs0; *(u32x4*)(V_lds + (bf) * VBYTES + v_st<NDB>(32 + sr, sc)) = st.vs1; \
        *(u32x4*)(K_lds + (bf) * KBYTES + kswz<RB>(sr, sc * 2)) = st.ks0; *(u32x4*)(K_lds + (bf) * KBYTES + kswz<RB>(32 + sr, sc * 2)) = st.ks1; \
        *(u32x4*)(K_lds + (bf) * KBYTES + kswz<RB>(rr_, 256 + rc * 2)) = st.kr; \
    } else { *(u32x4*)(V_lds + (bf) * VBYTES + v_st<NDB>(rr_, rc)) = st.vs0; *(u32x4*)(K_lds + (bf) * KBYTES + kswz<RB>(rr_, rc * 2)) = st.ks0; } } while (0)
#define RESC(a) do { if (__any((a) < 1.f)) { if (hi == 0) al_l[r32] = (a); asm volatile("s_waitcnt lgkmcnt(0)" ::: "memory"); \
    _Pragma("unroll") for (int d = 0; d < NDB; ++d) _Pragma("unroll") for (int r = 0; r < 16; ++r) o[d][r] *= al_l[crow(r, hi)]; } } while (0)
#define SCORE(P0, P1, j, bf) do { const int tt = t0 + (j); \
        if constexpr (MODE == 1) { const int qs = q0 + wid * 32 + r32, kb = 64 * tt + 4 * hi; \
            _Pragma("unroll") for (int r = 0; r < 16; ++r) { int d0_ = qs - (kb + (r & 3) + 8 * (r >> 2)); int d1_ = d0_ - 32; \
                d0_ = d0_ < -63 ? -63 : (d0_ > 256 ? 256 : d0_); d1_ = d1_ < -63 ? -63 : (d1_ > 256 ? 256 : d1_); P0[r] = relT[d0_ + 63]; P1[r] = relT[d1_ + 63]; } \
        } else { P0 = f32x16{}; P1 = f32x16{}; } \
        qkt<MODE>(P0, P1, kb4, (bf) * KBYTES, qr, qlds); \
        const bool vis = MODE == 0 ? (tt <= cw) : (tt <= cw && tt >= cw - 8); \
        if (!vis) { _Pragma("unroll") for (int r = 0; r < 16; ++r) { P0[r] = -INFINITY; P1[r] = -INFINITY; } } } while (0)
    f32x16 pA0, pA1, pB0, pB1; float alA, alB; bf16x8 pa0, pa1, pa2, pa3;
    SLOAD(64 * t0); asm volatile("s_waitcnt vmcnt(0)" ::: "memory"); SWRITE(0); __syncthreads();
    SCORE(pA0, pA1, 0, 0); partialSM<MODE>(pA0, pA1, m_reg, alA);
    SLOAD(64 * (t0 + 1)); asm volatile("s_waitcnt vmcnt(0)" ::: "memory"); SWRITE(1); __syncthreads();
    for (int j = 1; j + 1 < NT; j += 2) {
        SBAR(); SCORE(pB0, pB1, j, 1);
        finishSM(pA0, pA1, alA, l_reg, pa0, pa1, pa2, pa3); SBAR();
        SLOAD(64 * (t0 + j + 1)); SBAR();
        pv_all<NDB>(o, vb0, pa0, pa1, pa2, pa3); partialSM<MODE>(pB0, pB1, m_reg, alB);
        __syncthreads(); SWRITE(0);
        RESC(alB); __syncthreads();
        SBAR(); SCORE(pA0, pA1, j + 1, 0);
        finishSM(pB0, pB1, alB, l_reg, pa0, pa1, pa2, pa3); SBAR();
        SLOAD(64 * (t0 + j + 2)); SBAR();
        pv_all<NDB>(o, vb0 + VBYTES, pa0, pa1, pa2, pa3); partialSM<MODE>(pA0, pA1, m_reg, alA);
        __syncthreads(); SWRITE(1);
        RESC(alA); __syncthreads();
    }
    SBAR(); SCORE(pB0, pB1, NT - 1, 1);
    finishSM(pA0, pA1, alA, l_reg, pa0, pa1, pa2, pa3); SBAR();
    pv_all<NDB>(o, vb0, pa0, pa1, pa2, pa3); partialSM<MODE>(pB0, pB1, m_reg, alB);
    RESC(alB);
    finishSM(pB0, pB1, alB, l_reg, pa0, pa1, pa2, pa3); SBAR();
    pv_all<NDB>(o, vb0 + VBYTES, pa0, pa1, pa2, pa3);
    if (hi == 0) li_l[r32] = l_reg; asm volatile("s_waitcnt lgkmcnt(0)" ::: "memory");
    float rli[16];
#pragma unroll
    for (int r = 0; r < 16; ++r) rli[r] = __builtin_amdgcn_rcpf(li_l[crow(r, hi)]);
    __syncthreads();
    bf16_t* stg = (bf16_t*)(lds + wid * (32 * DV * 2));
#pragma unroll
    for (int r = 0; r < 16; ++r) { const int orow = crow(r, hi);
#pragma unroll
        for (int d0 = 0; d0 < NDB; ++d0) stg[orow * DV + d0 * 32 + r32] = (bf16_t)f2bf(o[d0][r] * rli[r]); }
    asm volatile("s_waitcnt lgkmcnt(0)" ::: "memory");
    bf16_t* Ow = Op + (rowbase + q0 + wid * 32) * D + ocol;
#pragma unroll
    for (int i = 0; i < DV / 16; ++i) { const int id = i * 64 + lane, row = id / (DV / 8), ch = id % (DV / 8);
        *(u32x4*)(Ow + (size_t)row * D + ch * 8) = *(const u32x4*)(stg + row * DV + ch * 8); }
    __syncthreads();
#undef SLOAD
#undef SWRITE
#undef RESC
#undef SCORE
}
#undef SBAR
}

__device__ __forceinline__ void ph_mla_attn_mfma(int wv, char* lds, const bf16_t* Q, const bf16_t* KV, const bf16_t* KR, bf16_t* O) {
    const int G = gridDim.x, bx = blockIdx.x, vcu = (G % 8 == 0) ? (bx % 8) * (G / 8) + bx / 8 : bx;
    for (int p = vcu; p < 256; p += G) {
        const int bh = p >> 3, s = p & 7;
#pragma unroll 1
        for (int i = 0; i < 2; ++i) att::attn_unit<0>(wv, lds, Q, KV, KV, KR, O, nullptr, bh >> 3, bh & 7, i ? s : 15 - s);
    }
}
__device__ __forceinline__ void ph_chunk_attn_mfma(int wv, char* lds, const bf16_t* KVQ, const float* rel, bf16_t* O) {
    const int G = gridDim.x, bx = blockIdx.x, vcu = (G % 8 == 0) ? (bx % 8) * (G / 8) + bx / 8 : bx;
    for (int p = vcu; p < 256; p += G) {
        const int bh = p >> 2, qd = p & 3;
#pragma unroll 1
        for (int i = 3; i >= 0; --i) att::attn_unit<1>(wv, lds, KVQ, KVQ, KVQ, nullptr, O, rel + (bh & 15) * RELT, bh >> 4, bh & 15, qd + 4 * i);
    }
}


template <class Epi> __device__ __forceinline__ void run_gemm(int wv, char* lds, const bf16_t* A, int lda, const bf16_t* Bt, int M, int N, int K, const Epi& E) {
    pg8::Gemm g{A, Bt, M, N, K, lda}; pg8::StaticOrder S; S.init(M, N, (int)gridDim.x, (int)blockIdx.x);
    pg8::gemm_phase<Epi, pg8::StaticOrder, true, true>(wv, (LAS unsigned char*)lds, g, S, E);
}

#define RLX_AGENT __ATOMIC_RELAXED, __HIP_MEMORY_SCOPE_AGENT
#define XB_TMO      128
#define XB_XCNT(j)  (256  + 64 * (j))
#define XB_XSUB(j)  (1280 + 64 * (j))
#define XB_XGEN(j)  (2304 + 64 * (j))
#define XB_TOP      3328
#define XB_TOPGEN   3392
#define XCD_BAR_WORDS 3456
#define XB_SPIN_CAP (1u << 18)

__device__ __forceinline__ unsigned xb_ld(unsigned* p)              { return __hip_atomic_load(p, __ATOMIC_RELAXED, __HIP_MEMORY_SCOPE_AGENT); }
__device__ __forceinline__ unsigned xb_add(unsigned* p, unsigned v) { return __hip_atomic_fetch_add(p, v, __ATOMIC_RELAXED, __HIP_MEMORY_SCOPE_AGENT); }
__device__ __forceinline__ unsigned xb_xcc_id() { return (unsigned)__builtin_amdgcn_s_getreg((3 << 11) | 20) & 0xFu; }
#define XB_SPIN(cond, bar) do { unsigned _sp = 0; while (cond) { __builtin_amdgcn_s_sleep(1); \
    if ((++_sp & 255u) == 0u) { if (xb_ld(&(bar)[XB_TMO])) break; if (_sp > XB_SPIN_CAP) { atomicAdd(&(bar)[XB_TMO], 1u); break; } } } } while (0)

struct XcdBarrier {
    unsigned* bar; unsigned x;
    volatile LAS unsigned* st;
};

__device__ __forceinline__ XcdBarrier xcd_barrier_post(int wv, unsigned* bar, volatile LAS unsigned* st) {
    XcdBarrier b; b.bar = bar; b.x = xb_xcc_id(); b.st = st;
    if (wv == 0 && lane_id() == 0) (void)xb_add(&bar[XB_XCNT(b.x)], 1u);
    return b;
}
__device__ __forceinline__ void xcd_barrier_complete(unsigned* bar, unsigned x, unsigned& nloc, unsigned& nx) {
    const unsigned G = gridDim.x * gridDim.y * gridDim.z;
    unsigned sum, cnt, mine, sp = 0u;
    for (;;) {
        sum = 0u; cnt = 0u; mine = 0u;
#pragma unroll
        for (unsigned j = 0; j < 16; ++j) { const unsigned c = xb_ld(&bar[XB_XCNT(j)]); sum += c; cnt += (c > 0u) ? 1u : 0u; mine = (j == x) ? c : mine; }
        if (sum == G) break;
        __builtin_amdgcn_s_sleep(1);
        if ((++sp & 255u) == 0u) { if (xb_ld(&bar[XB_TMO])) break; if (sp > XB_SPIN_CAP) { atomicAdd(&bar[XB_TMO], 1u); break; } }
    }
    nloc = mine > 0u ? mine : 1u; nx = cnt > 0u ? cnt : 1u;
}

__device__ __forceinline__ void xcd_barrier(int wv, const XcdBarrier& b) {
    asm volatile("s_waitcnt vmcnt(0)" ::: "memory");
    __syncthreads();
    if (wv == 0 && lane_id() == 0) {
        unsigned* bar = b.bar;
        __builtin_amdgcn_s_waitcnt(0);
        unsigned nloc = b.st[0], nx = b.st[1];
        if (nloc == 0u) { xcd_barrier_complete(bar, b.x, nloc, nx); b.st[0] = nloc; b.st[1] = nx; }
        const unsigned old = xb_add(&bar[XB_XSUB(b.x)], 1u);
        const unsigned gen = old / nloc;
        if (old + 1u == (gen + 1u) * nloc) {
            __builtin_amdgcn_fence(__ATOMIC_RELEASE, "agent");
            asm volatile("s_waitcnt vmcnt(0)" ::: "memory");
            const unsigned og = xb_add(&bar[XB_TOP], 1u);
            const unsigned tg = og / nx;
            if (og + 1u == (tg + 1u) * nx) xb_add(&bar[XB_TOPGEN], 1u);
            else XB_SPIN(xb_ld(&bar[XB_TOPGEN]) == tg, bar);
            __builtin_amdgcn_fence(__ATOMIC_ACQUIRE, "agent");
            xb_add(&bar[XB_XGEN(b.x)], 1u);
            asm volatile("s_waitcnt vmcnt(0)" ::: "memory");
        } else {
            XB_SPIN(xb_ld(&bar[XB_XGEN(b.x)]) == gen, bar);
            __builtin_amdgcn_fence(__ATOMIC_ACQUIRE, "agent");
            asm volatile("s_waitcnt vmcnt(0)" ::: "memory");
        }
    }
    __syncthreads();
}

__global__ void __launch_bounds__(NTHR, 2) mega_fwd(Params P) {
    extern __shared__ __attribute__((aligned(16))) char lds[];
    cg::grid_group grid = cg::this_grid();
    const int wv = __builtin_amdgcn_readfirstlane((int)threadIdx.x >> 6);
    volatile LAS unsigned* bst = (volatile LAS unsigned*)((LAS char*)lds + (LDS_BYTES - 64));
    if (wv == 0 && lane_id() < 16) bst[lane_id()] = 0u;
    __syncthreads();
    const XcdBarrier xbar = xcd_barrier_post(wv, (unsigned*)P.ws + 1024, bst);
#define GSYNC() xcd_barrier(wv, xbar)
    const float* x = P.in[0]; const int* pos = (const int*)P.in[1];
    const float *attn_pre_g = P.in[2], *attn_post_g = P.in[3], *ffn_pre_g = P.in[4], *ffn_post_g = P.in[5];
    const float *w_gate = P.in[6], *w_up = P.in[7], *w_down = P.in[8];
    const float *w_a = P.in[9], *g_q = P.in[10], *w_uq = P.in[11], *g_kv = P.in[12], *w_ukv = P.in[13], *w_o = P.in[14];
    const float *kv_src_g = P.in[15], *w_kvs = P.in[16], *b_w_q = P.in[17], *rel = P.in[18], *b_w_o = P.in[19];
    float* out = P.out; unsigned char* ws = P.ws;
    float *cosT = (float*)(ws + WS_COS), *sinT = (float*)(ws + WS_SIN);
    bf16_t *KR = (bf16_t*)(ws + WS_KR), *XN = (bf16_t*)(ws + WS_XN);
    bf16_t *Wa = (bf16_t*)(ws + W_A), *Wuq = (bf16_t*)(ws + W_UQ), *Wukv = (bf16_t*)(ws + W_UKV), *Wo = (bf16_t*)(ws + W_O);
    bf16_t *Wgu0 = (bf16_t*)(ws + W_GU0), *Wgu1 = (bf16_t*)(ws + W_GU1), *Wd0 = (bf16_t*)(ws + W_D0), *Wd1 = (bf16_t*)(ws + W_D1);
    bf16_t *Wkvq = (bf16_t*)(ws + W_KVQ), *Wbo = (bf16_t*)(ws + W_BO);
    bf16_t* ALAT = (bf16_t*)(ws + WS_ALAT); bf16_t* Q = (bf16_t*)(ws + WS_Q); bf16_t* KV = (bf16_t*)(ws + WS_KV); bf16_t* O = (bf16_t*)(ws + WS_O);
    float* Y0 = (float*)(ws + WS_Y0); bf16_t* H = (bf16_t*)(ws + WS_H); float* YF = (float*)(ws + WS_YF);
    bf16_t* KVQ = (bf16_t*)(ws + WS_KVQ); bf16_t* O1 = (bf16_t*)(ws + WS_O1); float* Y1 = (float*)(ws + WS_Y1);

    ph_wconv(wv, lds, w_a, nullptr, attn_pre_g, D, 704, NA, Wa, WM_WA);
    ph_wconv(wv, lds, w_uq, nullptr, g_q, QL, NQ, NQ, Wuq, WM_WUQ);
    ph_wconv(wv, lds, w_ukv, nullptr, g_kv, KVL, NKV, NKV, Wukv, WM_PLAIN);
    ph_wconv(wv, lds, w_o, nullptr, nullptr, D, D, D, Wo, WM_PLAIN);
    ph_wconv(wv, lds, w_gate, w_up, ffn_pre_g, D, DFF, 2 * DFF, Wgu0, WM_GU);
    ph_wconv(wv, lds, w_down, nullptr, nullptr, DFF, D, D, Wd0, WM_PLAIN);
    ph_wconv(wv, lds, w_gate + (size_t)D * DFF, w_up + (size_t)D * DFF, ffn_pre_g + D, D, DFF, 2 * DFF, Wgu1, WM_GU);
    ph_wconv(wv, lds, w_down + (size_t)DFF * D, nullptr, nullptr, DFF, D, D, Wd1, WM_PLAIN);
    ph_wconv(wv, lds, w_kvs, nullptr, kv_src_g, D, 2048, 2048, Wkvq, WM_PLAIN);
    ph_wconv(wv, lds, b_w_q, nullptr, attn_pre_g + D, D, D, D, Wkvq + (size_t)2048 * D, WM_PLAIN);
    ph_wconv(wv, lds, b_w_o, nullptr, nullptr, D, D, D, Wbo, WM_PLAIN);
    ph_rope_table(wv, pos, cosT, sinT);
    ph_rows_pre(wv, x, XN);
    grid.sync();
    run_gemm(wv, lds, XN, D, Wa, T, NA, D, pg8::EpiBf16{ALAT, NA, 1 << 30, 1.f});
    GSYNC();
    ph_lat_post(wv, ALAT, cosT, sinT, KR);
    GSYNC();
    run_gemm(wv, lds, ALAT, NA, Wuq, T, NQ, QL, pg8::EpiBf16{Q, NQ, 1 << 30, 1.f});
    run_gemm(wv, lds, ALAT + QL, NA, Wukv, T, NKV, KVL, pg8::EpiBf16{KV, NKV, 1 << 30, 1.f});
    GSYNC();
    ph_rope_q(wv, Q, cosT, sinT);
    GSYNC();
    ph_mla_attn_mfma(wv, lds, Q, KV, KR, O);
    GSYNC();
    run_gemm(wv, lds, O, D, Wo, T, D, D, pg8::EpiF32{Y0, D});
    GSYNC();
    ph_rows_post(wv, x, Y0, attn_post_g, out, XN);
    GSYNC();
    run_gemm(wv, lds, XN, D, Wgu0, T, 2 * DFF, D, pg8::EpiSwiglu{H, DFF});
    GSYNC();
    run_gemm(wv, lds, H, DFF, Wd0, T, D, DFF, pg8::EpiF32{YF, D});
    GSYNC();
    ph_rows_post(wv, out, YF, ffn_post_g, out, XN);
    GSYNC();
    run_gemm(wv, lds, XN, D, Wkvq, T, 3072, D, pg8::EpiBf16{KVQ, 3072, 1 << 30, 1.f});
    GSYNC();
    ph_chunk_attn_mfma(wv, lds, KVQ, rel, O1);
    GSYNC();
    run_gemm(wv, lds, O1, D, Wbo, T, D, D, pg8::EpiF32{Y1, D});
    GSYNC();
    ph_rows_post(wv, out, Y1, attn_post_g + D, out, XN);
    GSYNC();
    run_gemm(wv, lds, XN, D, Wgu1, T, 2 * DFF, D, pg8::EpiSwiglu{H, DFF});
    GSYNC();
    run_gemm(wv, lds, H, DFF, Wd1, T, D, DFF, pg8::EpiF32{YF, D});
    GSYNC();
    ph_rows_post(wv, out, YF, ffn_post_g + D, out, nullptr);
}

extern "C" void kernel_launch(void* const* d_in, const int* in_sizes, int n_in, void* d_out, int out_size, void* d_ws, size_t ws_size, hipStream_t stream) {
    static int grid_blocks = 0;
    if (grid_blocks == 0) {
        int dev = 0, cus = 0, per_cu = 0;
        (void)hipGetDevice(&dev);
        (void)hipDeviceGetAttribute(&cus, hipDeviceAttributeMultiprocessorCount, dev);
        if (hipFuncSetAttribute((const void*)mega_fwd, hipFuncAttributeMaxDynamicSharedMemorySize, LDS_BYTES) != hipSuccess) { fprintf(stderr, "hipFuncSetAttribute failed\n"); grid_blocks = -1; return; }
        if (hipOccupancyMaxActiveBlocksPerMultiprocessor(&per_cu, (const void*)mega_fwd, NTHR, LDS_BYTES) != hipSuccess || per_cu < 1) { fprintf(stderr, "occupancy query: %d\n", per_cu); grid_blocks = -1; return; }
        grid_blocks = cus * per_cu;
    }
    if (grid_blocks < 0) return;
    if (hipMemsetAsync(d_ws, 0, 65536, stream) != hipSuccess) { fprintf(stderr, "memset failed\n"); return; }
    Params p{};
    for (int i = 0; i < 20; ++i) p.in[i] = (const float*)d_in[i];
    p.out = (float*)d_out; p.ws = (unsigned char*)d_ws;
    void* args[] = {&p};
    hipError_t e = hipLaunchCooperativeKernel((const void*)mega_fwd, dim3(grid_blocks), dim3(NTHR), args, LDS_BYTES, stream);
    if (e != hipSuccess) fprintf(stderr, "cooperative launch failed: %s (grid %d)\n", hipGetErrorString(e), grid_blocks);
}
```
